# Optimizing an MI355X kernel written in HIP

```python
import math
import jax, jax.numpy as jnp
from jax import lax
import numpy as np

D_MODEL = 1024
BATCH = 4
SEQ = 4096
DEPTH = 1

HEAD_DIM = 64
N_DIFF_HEADS = 4
DIFF_V_DIM = 2 * HEAD_DIM
N_SWA_HEADS = 8
N_SWA_KV = 2
SWA_GROUP = N_SWA_HEADS // N_SWA_KV
WINDOW = 128
BLOCK = 128
N_META = 16
N_BUCKETS = 32
MAX_DISTANCE = 128
N_BIAS_HEADS = N_DIFF_HEADS + N_SWA_HEADS
N_GROUPS = 4
EXPERTS_PER_GROUP = 8
N_EXPERTS = N_GROUPS * EXPERTS_PER_GROUP
TOP_K = 2
D_EXPERT = 512
MOE_BLOCK = 128
EPS = 1e-6
NEG = -1e30

DIFF_QK = N_DIFF_HEADS * 2 * HEAD_DIM
DIFF_V = N_DIFF_HEADS * DIFF_V_DIM
SWA_Q = N_SWA_HEADS * HEAD_DIM
SWA_KV = N_SWA_KV * HEAD_DIM
D_IN = 2 * DIFF_QK + DIFF_V + SWA_Q + 2 * SWA_KV
D_MIX = DIFF_V + SWA_Q

kernel_name = "hymba_diffattn_swasink_hmoe"


def rmsnorm(x, g):
    xf = x.astype(jnp.float32)
    y = xf * lax.rsqrt(jnp.mean(xf * xf, axis=-1, keepdims=True) + EPS)
    return (y * g.astype(jnp.float32)).astype(x.dtype)


def t5_bucket(dist):
    n = jnp.maximum(dist, 0)
    max_exact = N_BUCKETS // 2
    nf = jnp.maximum(n, 1).astype(jnp.float32)
    large = max_exact + (jnp.log(nf / max_exact) / math.log(MAX_DISTANCE / max_exact)
                         * (N_BUCKETS - max_exact)).astype(jnp.int32)
    large = jnp.minimum(large, N_BUCKETS - 1)
    return jnp.where(n < max_exact, n, large)


def diff_attention(q, k, v, q_gain, k_gain, lam_q1, lam_k1, lam_q2, lam_k2, subln_gain,
                   bias_table, pos, lambda_init):
    B, Lp, H, _, d = q.shape
    nb = Lp // BLOCK
    q = rmsnorm(q, q_gain)
    k = rmsnorm(k, k_gain)
    lam = (jnp.exp(jnp.sum(lam_q1.astype(jnp.float32) * lam_k1.astype(jnp.float32)))
           - jnp.exp(jnp.sum(lam_q2.astype(jnp.float32) * lam_k2.astype(jnp.float32)))
           + lambda_init)
    scale = d ** -0.5
    qb = q.reshape(B, nb, BLOCK, H, 2, d).transpose(1, 0, 2, 3, 4, 5)

    def block(args):
        qblk, qpos = args
        s = jnp.einsum('bqhmd,bkhmd->bhmqk', qblk, k).astype(jnp.float32) * scale
        dist = qpos[:, None] - pos[None, :]
        bias = bias_table[t5_bucket(dist)].transpose(2, 0, 1)
        s = s + bias[None, :, None].astype(jnp.float32)
        mask = (dist >= 0) & (pos[None, :] >= 0)
        s = jnp.where(mask, s, NEG)
        p = jax.nn.softmax(s, axis=-1)
        a = p[:, :, 0] - lam * p[:, :, 1]
        return jnp.einsum('bhqk,bkhe->bqhe', a.astype(v.dtype), v)

    o = lax.map(block, (qb, pos.reshape(nb, BLOCK)))
    o = o.transpose(1, 0, 2, 3, 4).reshape(B, Lp, H, DIFF_V_DIM)
    o = rmsnorm(o, subln_gain) * (1.0 - lambda_init)
    return o.reshape(B, Lp, H * DIFF_V_DIM)


def swa_sink_attention(q, k, v, q_gain, k_gain, sinks, bias_table, pos, n_pad):
    B, Lp, Hq, d = q.shape
    nb = Lp // BLOCK
    q = rmsnorm(q, q_gain)
    k = rmsnorm(k, k_gain)
    qb = q.reshape(B, nb, BLOCK, N_SWA_KV, SWA_GROUP, d)

    def keys(t):
        tb = t.reshape(B, nb, BLOCK, N_SWA_KV, d)
        prev = jnp.pad(tb[:, :-1], ((0, 0), (1, 0), (0, 0), (0, 0), (0, 0)))
        meta = jnp.broadcast_to(t[:, None, n_pad:n_pad + N_META], (B, nb, N_META, N_SWA_KV, d))
        return jnp.concatenate([meta, prev, tb], axis=2)

    kb, vb = keys(k), keys(v)
    posb = pos.reshape(nb, BLOCK)
    prev_pos = jnp.pad(posb[:-1], ((1, 0), (0, 0)), constant_values=-1)
    meta_pos = jnp.broadcast_to(pos[n_pad:n_pad + N_META], (nb, N_META))
    kpos = jnp.concatenate([meta_pos, prev_pos, posb], axis=1)
    dist = posb[:, :, None] - kpos[:, None, :]
    is_meta = (jnp.arange(kpos.shape[1]) < N_META)[None, None, :]
    band = (dist < WINDOW) & (kpos[:, None, :] >= N_META)
    mask = (dist >= 0) & (is_meta | band)
    bias = bias_table[t5_bucket(dist)]
    bias = bias.transpose(0, 3, 1, 2).reshape(nb, N_SWA_KV, SWA_GROUP, BLOCK, kpos.shape[1])
    s = jnp.einsum('bnqgrd,bnkgd->bngrqk', qb, kb).astype(jnp.float32) * (d ** -0.5)
    s = s + bias[None].astype(jnp.float32)
    s = jnp.where(mask[None, :, None, None], s, NEG)
    sink = jnp.broadcast_to(sinks.astype(jnp.float32).reshape(1, 1, N_SWA_KV, SWA_GROUP, 1, 1),
                            s.shape[:-1] + (1,))
    p = jax.nn.softmax(jnp.concatenate([s, sink], axis=-1), axis=-1)[..., :-1]
    o = jnp.einsum('bngrqk,bnkgd->bnqgrd', p.astype(v.dtype), vb)
    return o.reshape(B, Lp, Hq * d)


def hier_moe(x, w_group, b_group, w_router, b_router, w_gate, w_up, w_down):
    B, Lp, D = x.shape
    N = B * Lp
    t = x.reshape(N, D)
    gl = (t @ w_group).astype(jnp.float32) + b_group.astype(jnp.float32)
    g = jnp.argmax(gl, axis=-1)
    g_w = jnp.take_along_axis(jax.nn.softmax(gl, axis=-1), g[:, None], axis=1)
    el = ((t @ w_router).astype(jnp.float32) + b_router.astype(jnp.float32)).reshape(
        N, N_GROUPS, EXPERTS_PER_GROUP)
    el = jnp.take_along_axis(el, g[:, None, None], axis=1)[:, 0]
    top_l, top_j = lax.top_k(el, TOP_K)
    gates = (jax.nn.softmax(top_l, axis=-1) * g_w).reshape(-1)
    eid = (g[:, None] * EXPERTS_PER_GROUP + top_j).reshape(-1).astype(jnp.int32)
    NK = N * TOP_K
    tok = (jnp.arange(NK, dtype=jnp.int32) // TOP_K)

    order = jnp.argsort(eid)
    se = eid[order]
    counts = jnp.bincount(eid, length=N_EXPERTS)
    start = jnp.cumsum(counts) - counts
    padded = (counts + MOE_BLOCK - 1) // MOE_BLOCK * MOE_BLOCK
    pend = jnp.cumsum(padded)
    pstart = pend - padded
    dest = pstart[se] + jnp.arange(NK, dtype=jnp.int32) - start[se]
    n_blocks = -(-(NK + N_EXPERTS * (MOE_BLOCK - 1)) // MOE_BLOCK)
    P = n_blocks * MOE_BLOCK
    tok_buf = jnp.full((P,), N, jnp.int32).at[dest].set(tok[order])
    gate_buf = jnp.zeros((P,), jnp.float32).at[dest].set(gates[order])
    blk_e = jnp.minimum(jnp.searchsorted(pend, jnp.arange(n_blocks) * MOE_BLOCK, side='right'),
                        N_EXPERTS - 1)
    t_pad = jnp.concatenate([t, jnp.zeros((1, D), t.dtype)], axis=0)
    xs = t_pad[tok_buf].reshape(n_blocks, MOE_BLOCK, D)

    def expert_block(args):
        xb, e = args
        hdn = jax.nn.silu(xb @ w_gate[e]) * (xb @ w_up[e])
        return hdn @ w_down[e]

    ys = lax.map(expert_block, (xs, blk_e)).reshape(P, D)
    ys = ys * gate_buf[:, None].astype(ys.dtype)
    out = jax.ops.segment_sum(ys, tok_buf, num_segments=N + 1)[:N]
    return out.reshape(B, Lp, D)


def setup_inputs(seed: int = 0) -> dict:
    key = jax.random.key(seed)
    ks = jax.random.split(key, 24)
    f = jnp.float32

    def nrm(k, shape, s):
        return jax.random.normal(k, shape, f) * s

    return {
        "x": nrm(ks[0], (BATCH, SEQ, D_MODEL), 1.0),
        "meta_tokens": nrm(ks[1], (N_META, D_MODEL), 1.0),
        "rel_bias": nrm(ks[2], (N_BUCKETS, N_BIAS_HEADS), 0.5),
        "norm1_gain": 1.0 + nrm(ks[3], (DEPTH, D_MODEL), 0.1),
        "w_in": nrm(ks[4], (DEPTH, D_MODEL, D_IN), D_MODEL ** -0.5),
        "diff_q_gain": 1.0 + nrm(ks[5], (DEPTH, HEAD_DIM), 0.1),
        "diff_k_gain": 1.0 + nrm(ks[6], (DEPTH, HEAD_DIM), 0.1),
        "lam_q1": nrm(ks[7], (DEPTH, HEAD_DIM), 0.1),
        "lam_k1": nrm(ks[8], (DEPTH, HEAD_DIM), 0.1),
        "lam_q2": nrm(ks[9], (DEPTH, HEAD_DIM), 0.1),
        "lam_k2": nrm(ks[10], (DEPTH, HEAD_DIM), 0.1),
        "diff_subln_gain": 1.0 + nrm(ks[11], (DEPTH, DIFF_V_DIM), 0.1),
        "swa_q_gain": 1.0 + nrm(ks[12], (DEPTH, HEAD_DIM), 0.1),
        "swa_k_gain": 1.0 + nrm(ks[13], (DEPTH, HEAD_DIM), 0.1),
        "swa_sinks": nrm(ks[14], (DEPTH, N_SWA_HEADS), 1.0),
        "w_out": nrm(ks[15], (DEPTH, D_MIX, D_MODEL), D_MIX ** -0.5),
        "norm2_gain": 1.0 + nrm(ks[16], (DEPTH, D_MODEL), 0.1),
        "w_group": nrm(ks[17], (DEPTH, D_MODEL, N_GROUPS), D_MODEL ** -0.5),
        "b_group": nrm(ks[18], (DEPTH, N_GROUPS), 0.01),
        "w_router": nrm(ks[19], (DEPTH, D_MODEL, N_EXPERTS), D_MODEL ** -0.5),
        "b_router": nrm(ks[20], (DEPTH, N_EXPERTS), 0.01),
        "w_gate": nrm(ks[21], (DEPTH, N_EXPERTS, D_MODEL, D_EXPERT), D_MODEL ** -0.5),
        "w_up": nrm(ks[22], (DEPTH, N_EXPERTS, D_MODEL, D_EXPERT), D_MODEL ** -0.5),
        "w_down": nrm(ks[23], (DEPTH, N_EXPERTS, D_EXPERT, D_MODEL), D_EXPERT ** -0.5),
    }


def reference(x, meta_tokens, rel_bias, norm1_gain, w_in, diff_q_gain, diff_k_gain,
              lam_q1, lam_k1, lam_q2, lam_k2, diff_subln_gain, swa_q_gain, swa_k_gain,
              swa_sinks, w_out, norm2_gain, w_group, b_group, w_router, b_router,
              w_gate, w_up, w_down):
    B, S, D = x.shape
    L = S + N_META
    nb = -(-L // BLOCK)
    n_pad = nb * BLOCK - L
    meta = jnp.broadcast_to(meta_tokens[None].astype(x.dtype), (B, N_META, D))
    h = jnp.concatenate([jnp.zeros((B, n_pad, D), x.dtype), meta, x], axis=1)
    Lp = h.shape[1]
    pos = jnp.arange(Lp, dtype=jnp.int32) - n_pad
    split_at = [DIFF_QK, 2 * DIFF_QK, 2 * DIFF_QK + DIFF_V,
                2 * DIFF_QK + DIFF_V + SWA_Q, 2 * DIFF_QK + DIFF_V + SWA_Q + SWA_KV]
    for layer in range(DEPTH):
        lambda_init = 0.8 - 0.6 * math.exp(-0.3 * layer)
        a = rmsnorm(h, norm1_gain[layer])
        proj = a @ w_in[layer]
        dq, dk, dv, sq, sk, sv = jnp.split(proj, split_at, axis=-1)
        o_diff = diff_attention(
            dq.reshape(B, Lp, N_DIFF_HEADS, 2, HEAD_DIM),
            dk.reshape(B, Lp, N_DIFF_HEADS, 2, HEAD_DIM),
            dv.reshape(B, Lp, N_DIFF_HEADS, DIFF_V_DIM),
            diff_q_gain[layer], diff_k_gain[layer],
            lam_q1[layer], lam_k1[layer], lam_q2[layer], lam_k2[layer],
            diff_subln_gain[layer], rel_bias[:, :N_DIFF_HEADS], pos, lambda_init)
        o_swa = swa_sink_attention(
            sq.reshape(B, Lp, N_SWA_HEADS, HEAD_DIM),
            sk.reshape(B, Lp, N_SWA_KV, HEAD_DIM),
            sv.reshape(B, Lp, N_SWA_KV, HEAD_DIM),
            swa_q_gain[layer], swa_k_gain[layer], swa_sinks[layer],
            rel_bias[:, N_DIFF_HEADS:], pos, n_pad)
        mix = jnp.concatenate([o_diff, o_swa], axis=-1)
        h = h + mix @ w_out[layer]
        h = h + hier_moe(rmsnorm(h, norm2_gain[layer]), w_group[layer], b_group[layer],
                         w_router[layer], b_router[layer], w_gate[layer], w_up[layer],
                         w_down[layer])
    return h[:, n_pad + N_META:]
```

```cpp
#include <hip/hip_runtime.h>
#include <cstdio>
#include <cstdint>

typedef unsigned short bf16;
typedef unsigned u32x4 __attribute__((ext_vector_type(4)));
typedef unsigned u32x2 __attribute__((ext_vector_type(2)));
typedef float f32x4 __attribute__((ext_vector_type(4)));

constexpr int NB = 4, SEQ = 4096, D = 1024, NTOK = NB * SEQ, NMETA = 16;
constexpr int MROWS = NTOK + 256;
constexpr int DIN = 2304;
constexpr int C_DQ = 0, C_DK = 512, C_DV = 1024, C_SQ = 1536, C_SK = 2048, C_SV = 2176;
constexpr int NEXP = 32, DEXP = 512;
constexpr int MAXSLOT = 40960;
constexpr float EPS = 1e-6f;
constexpr float LOG2E = 1.4426950408889634f;
constexpr float C2 = 0.125f * LOG2E;

constexpr size_t MiB = 1u << 20;
constexpr size_t WS_CTL = 0, CTL_ZERO_BYTES = 1 * MiB;
constexpr size_t WS_SM = 1 * MiB;
constexpr size_t WS_TOK = 2 * MiB;
constexpr size_t WS_WIN = 4 * MiB, WS_WOUT = 9 * MiB, WS_WGU = 12 * MiB, WS_WD = 76 * MiB;
constexpr size_t WS_R1 = 108 * MiB;
constexpr size_t WS_R2 = 188 * MiB;
constexpr size_t WS_END = 228 * MiB;
constexpr int CW_CNT = 8192;
constexpr int SM_BIASD = 0, SM_BIASS = 512, SM_LAM = 1536;
constexpr size_t TOK_EP = 0, TOK_GATE = 131072, TOK_GSLOT = 262144, TOK_TILEE = 262144 + 163840, TOK_NT = TOK_TILEE + 1024;

__device__ __forceinline__ float bf2f(bf16 v) { return __builtin_bit_cast(float, (unsigned)v << 16); }
__device__ __forceinline__ unsigned f2bf(float f) { unsigned u = __builtin_bit_cast(unsigned, f); return (u + 0x7fffu + ((u >> 16) & 1u)) >> 16; }
__device__ __forceinline__ unsigned pk2(float lo, float hi) { return f2bf(lo) | (f2bf(hi) << 16); }
__device__ __forceinline__ float wave_sum(float v) {
#pragma unroll
    for (int o = 1; o < 64; o <<= 1) v += __shfl_xor(v, o);
    return v;
}
__device__ __forceinline__ int t5_bucket(int n) {
    if (n < 16) return n;
    const int st[16] = {16, 19, 21, 24, 27, 31, 35, 40, 46, 52, 59, 67, 77, 87, 99, 113};
    int b = 15;
#pragma unroll
    for (int i = 0; i < 16; ++i) b += (n >= st[i]) ? 1 : 0;
    return b;
}
__host__ __device__ __forceinline__ int win_row_of_col(int c) { const int T = c >> 8, r = c & 255, wc = r >> 6, bj = (r >> 5) & 1, i = r & 31; return T * 256 + bj * 128 + wc * 32 + i; }

struct Ptrs {
    const float *x, *meta, *rel_bias, *g1, *w_in, *dqg, *dkg, *lq1, *lk1, *lq2, *lk2, *subg, *sqg, *skg, *sinks, *w_out, *g2, *w_group, *b_group, *w_router, *b_router, *w_gate, *w_up, *w_down;
    float* out; unsigned char* ws;
};

__device__ __forceinline__ void transpose_item(const float* W, int K, int N, bf16* WT, int k0, int n0, int drow0, float* scr, int lane) {
#pragma unroll 8
    for (int i = 0; i < 32; ++i) { const int kk = 2 * i + (lane >> 5); scr[kk * 33 + (lane & 31)] = W[(size_t)(k0 + kk) * N + n0 + (lane & 31)]; }
    asm volatile("s_waitcnt lgkmcnt(0)" ::: "memory");
    const int c = lane & 7;
#pragma unroll
    for (int j = 0; j < 4; ++j) { const int n = (lane >> 3) + 8 * j; const float* s = scr + (8 * c) * 33 + n;
        u32x4 o; o.x = pk2(s[0 * 33], s[1 * 33]); o.y = pk2(s[2 * 33], s[3 * 33]); o.z = pk2(s[4 * 33], s[5 * 33]); o.w = pk2(s[6 * 33], s[7 * 33]);
        *(u32x4*)(WT + (size_t)(drow0 + n) * K + k0 + 8 * c) = o; }
    asm volatile("s_waitcnt lgkmcnt(0)" ::: "memory");
}

__global__ void __launch_bounds__(256) k_convert(Ptrs p) {
    __shared__ float scr_all[4][64 * 33];
    const int lane = threadIdx.x & 63, wave = threadIdx.x >> 6;
    float* scr = scr_all[wave];
    const int gw = blockIdx.x * 4 + wave, NGW = gridDim.x * 4;
    bf16* Wt_in = (bf16*)(p.ws + WS_WIN); bf16* Wt_out = (bf16*)(p.ws + WS_WOUT); bf16* Wgu = (bf16*)(p.ws + WS_WGU); bf16* Wd = (bf16*)(p.ws + WS_WD);
    constexpr int I_IN = (D / 64) * (DIN / 32), I_OUT = (D / 64) * (D / 32), I_G = (D / 64) * (DEXP / 32), I_DN = (DEXP / 64) * (D / 32);
    constexpr int NITEMS = I_IN + I_OUT + NEXP * (2 * I_G + I_DN);
    for (int it = gw; it < NITEMS; it += NGW) {
        int r = it;
        if (r < I_IN) { const int nblk = DIN / 32, kb = r / nblk, nb = r % nblk; transpose_item(p.w_in, D, DIN, Wt_in, 64 * kb, 32 * nb, win_row_of_col(32 * nb), scr, lane); continue; } r -= I_IN;
        if (r < I_OUT) { const int nblk = D / 32, kb = r / nblk, nb = r % nblk; transpose_item(p.w_out, D, D, Wt_out, 64 * kb, 32 * nb, 32 * nb, scr, lane); continue; } r -= I_OUT;
        const int e = r / (2 * I_G + I_DN); r -= e * (2 * I_G + I_DN);
        if (r < 2 * I_G) { const int up = r / I_G; r -= up * I_G; const int nblk = DEXP / 32, kb = r / nblk, nb = r % nblk; const int c0 = 32 * nb;
            transpose_item((up ? p.w_up : p.w_gate) + (size_t)e * D * DEXP, D, DEXP, Wgu + (size_t)e * 1024 * D, 64 * kb, c0, 256 * (c0 >> 7) + 128 * up + (c0 & 127), scr, lane); continue; }
        r -= 2 * I_G;
        { const int nblk = D / 32, kb = r / nblk, nb = r % nblk; transpose_item(p.w_down + (size_t)e * DEXP * D, DEXP, D, Wd + (size_t)e * D * DEXP, 64 * kb, 32 * nb, 32 * nb, scr, lane); }
    }
    bf16* A = (bf16*)(p.ws + WS_R2);
    for (int m = gw; m < MROWS; m += NGW) {
        u32x2* o8 = (u32x2*)(A + (size_t)m * D) + lane;
        if (m >= NTOK + NMETA) {
#pragma unroll
            for (int j = 0; j < 4; ++j) o8[64 * j] = (u32x2){0u, 0u};
            continue; }
        const float* xrow = (m < NTOK) ? p.x + (size_t)m * D : p.meta + (size_t)(m - NTOK) * D;
        const f32x4* xr = (const f32x4*)xrow + lane;
        f32x4 v[4]; float s = 0.f;
#pragma unroll
        for (int j = 0; j < 4; ++j) { v[j] = xr[64 * j]; s += (v[j].x * v[j].x + v[j].y * v[j].y) + (v[j].z * v[j].z + v[j].w * v[j].w); }
        const float rstd = 1.f / sqrtf(wave_sum(s) * (1.f / D) + EPS);
#pragma unroll
        for (int j = 0; j < 4; ++j) { const f32x4 g = ((const f32x4*)p.g1)[lane + 64 * j];
            o8[64 * j] = (u32x2){pk2(v[j].x * rstd * g.x, v[j].y * rstd * g.y), pk2(v[j].z * rstd * g.z, v[j].w * rstd * g.w)}; }
    }
    if (blockIdx.x == 0) {
        float* sm = (float*)(p.ws + WS_SM);
        for (int i = threadIdx.x; i < 12 * 128; i += 256) { const int hd = i >> 7, dist = i & 127; sm[i] = p.rel_bias[t5_bucket(dist) * 12 + hd] * LOG2E; }
        if (threadIdx.x < 64) { const int l = threadIdx.x; const float a = wave_sum(p.lq1[l] * p.lk1[l]), b = wave_sum(p.lq2[l] * p.lk2[l]); if (l == 0) sm[SM_LAM] = expf(a) - expf(b) + 0.2f; }
    }
}

template <int MODE> __global__ void __launch_bounds__(256) k_gemm(Ptrs p, int K) {
    __shared__ float As[16][68], Bs[16][68], Bs2[16][68];
    const int tid = threadIdx.x, tx = tid & 15, ty = tid >> 4;
    const int row0 = blockIdx.y * 64, col0 = blockIdx.x * 64;
    const bf16* A; const bf16* Bt; const bf16* Bt2 = nullptr;
    int brow0 = 0, brow1 = 0;
    if (MODE == 0) { A = (const bf16*)(p.ws + WS_R2); Bt = (const bf16*)(p.ws + WS_WIN); }
    else if (MODE == 1) { A = (const bf16*)(p.ws + WS_R2); Bt = (const bf16*)(p.ws + WS_WOUT); }
    else {
        const int nt = *(const int*)(p.ws + WS_TOK + TOK_NT); if (row0 >= nt * 256) return;
        const int e = ((const int*)(p.ws + WS_TOK + TOK_TILEE))[row0 >> 8];
        if (MODE == 2) { A = (const bf16*)(p.ws + WS_R1); Bt = (const bf16*)(p.ws + WS_WGU) + (size_t)e * 1024 * D; }
        else { A = (const bf16*)(p.ws + WS_R2); Bt = (const bf16*)(p.ws + WS_WD) + (size_t)e * D * DEXP; }
    }
    float acc[4][4] = {}, acc2[4][4] = {};
    const int lr = tid >> 2, lk = (tid & 3) * 4;
    int brow, brow2 = 0;
    { const int c = col0 + lr;
      if (MODE == 0) brow = win_row_of_col(c);
      else if (MODE == 2) { brow = 256 * (c >> 7) + (c & 127); brow2 = brow + 128; }
      else brow = c; }
    (void)brow0; (void)brow1; (void)Bt2;
    for (int k0 = 0; k0 < K; k0 += 16) {
        { const u32x2 a = *(const u32x2*)(A + (size_t)(row0 + lr) * K + k0 + lk);
          As[lk + 0][lr] = bf2f(a.x & 0xffff); As[lk + 1][lr] = bf2f(a.x >> 16); As[lk + 2][lr] = bf2f(a.y & 0xffff); As[lk + 3][lr] = bf2f(a.y >> 16);
          const u32x2 b = *(const u32x2*)(Bt + (size_t)brow * K + k0 + lk);
          Bs[lk + 0][lr] = bf2f(b.x & 0xffff); Bs[lk + 1][lr] = bf2f(b.x >> 16); Bs[lk + 2][lr] = bf2f(b.y & 0xffff); Bs[lk + 3][lr] = bf2f(b.y >> 16);
          if (MODE == 2) { const u32x2 b2 = *(const u32x2*)(Bt + (size_t)brow2 * K + k0 + lk);
            Bs2[lk + 0][lr] = bf2f(b2.x & 0xffff); Bs2[lk + 1][lr] = bf2f(b2.x >> 16); Bs2[lk + 2][lr] = bf2f(b2.y & 0xffff); Bs2[lk + 3][lr] = bf2f(b2.y >> 16); } }
        __syncthreads();
#pragma unroll
        for (int kk = 0; kk < 16; ++kk) {
            float a[4], b[4], b2[4];
#pragma unroll
            for (int i = 0; i < 4; ++i) { a[i] = As[kk][ty * 4 + i]; b[i] = Bs[kk][tx * 4 + i]; if (MODE == 2) b2[i] = Bs2[kk][tx * 4 + i]; }
#pragma unroll
            for (int i = 0; i < 4; ++i)
#pragma unroll
                for (int j = 0; j < 4; ++j) { acc[i][j] += a[i] * b[j]; if (MODE == 2) acc2[i][j] += a[i] * b2[j]; }
        }
        __syncthreads();
    }
    if (MODE == 0) {
        bf16* P = (bf16*)(p.ws + WS_R1);
        const int chunk = col0 >> 6;
        int kind; const float* gain = nullptr; float sc = 1.f;
        if (chunk < 8) { kind = 1; gain = p.dqg; sc = C2; } else if (chunk < 16) { kind = 1; gain = p.dkg; } else if (chunk < 24) { kind = 0; }
        else if (chunk < 32) { kind = 1; gain = p.sqg; sc = C2; } else if (chunk < 34) { kind = 1; gain = p.skg; } else kind = 0;
#pragma unroll
        for (int i = 0; i < 4; ++i) {
            float ss = 0.f;
#pragma unroll
            for (int j = 0; j < 4; ++j) ss += acc[i][j] * acc[i][j];
            ss += __shfl_xor(ss, 1); ss += __shfl_xor(ss, 2); ss += __shfl_xor(ss, 4); ss += __shfl_xor(ss, 8);
            const float rstd = kind ? 1.f / sqrtf(ss * (1.f / 64.f) + EPS) : 1.f;
            float v[4];
#pragma unroll
            for (int j = 0; j < 4; ++j) v[j] = kind ? acc[i][j] * rstd * gain[tx * 4 + j] * sc : acc[i][j];
            *(u32x2*)(P + (size_t)(row0 + ty * 4 + i) * DIN + col0 + tx * 4) = (u32x2){pk2(v[0], v[1]), pk2(v[2], v[3])};
        }
    } else if (MODE == 1) {
#pragma unroll
        for (int i = 0; i < 4; ++i) { const size_t o = (size_t)(row0 + ty * 4 + i) * D + col0 + tx * 4; const f32x4 xv = *(const f32x4*)(p.x + o);
            *(f32x4*)(p.out + o) = (f32x4){xv.x + acc[i][0], xv.y + acc[i][1], xv.z + acc[i][2], xv.w + acc[i][3]}; }
    } else if (MODE == 2) {
        bf16* H = (bf16*)(p.ws + WS_R2);
#pragma unroll
        for (int i = 0; i < 4; ++i) { float v[4];
#pragma unroll
            for (int j = 0; j < 4; ++j) { const float g = acc[i][j]; v[j] = g / (1.f + __expf(-g)) * acc2[i][j]; }
            *(u32x2*)(H + (size_t)(row0 + ty * 4 + i) * DEXP + col0 + tx * 4) = (u32x2){pk2(v[0], v[1]), pk2(v[2], v[3])}; }
    } else {
        bf16* Y = (bf16*)(p.ws + WS_R1); const float* gs = (const float*)(p.ws + WS_TOK + TOK_GSLOT);
#pragma unroll
        for (int i = 0; i < 4; ++i) { const int r = row0 + ty * 4 + i; const float g = gs[r];
            *(u32x2*)(Y + (size_t)r * D + col0 + tx * 4) = (u32x2){pk2(acc[i][0] * g, acc[i][1] * g), pk2(acc[i][2] * g, acc[i][3] * g)}; }
    }
}

__global__ void __launch_bounds__(64) k_attn_diff(Ptrs p) {
    const bf16* P = (const bf16*)(p.ws + WS_R1); bf16* mix = (bf16*)(p.ws + WS_R2); const float* sm = (const float*)(p.ws + WS_SM);
    const int lane = threadIdx.x, ch = lane & 3, tok = blockIdx.x * 16 + (lane >> 2), h = blockIdx.y;
    const int b = tok / SEQ, tq = tok % SEQ, tmax = (blockIdx.x * 16 + 15) % SEQ;
    const float* bias = sm + SM_BIASD + h * 128;
    float on[2][32];
#pragma unroll
    for (int m = 0; m < 2; ++m) {
        float q[64];
        { const u32x4* qp = (const u32x4*)(P + (size_t)tok * DIN + C_DQ + h * 128 + m * 64);
#pragma unroll
          for (int d = 0; d < 8; ++d) { const u32x4 w = qp[d]; q[8*d] = bf2f(w.x & 0xffff); q[8*d+1] = bf2f(w.x >> 16); q[8*d+2] = bf2f(w.y & 0xffff); q[8*d+3] = bf2f(w.y >> 16); q[8*d+4] = bf2f(w.z & 0xffff); q[8*d+5] = bf2f(w.z >> 16); q[8*d+6] = bf2f(w.w & 0xffff); q[8*d+7] = bf2f(w.w >> 16); } }
        float mr = -1e30f, l = 0.f, o[32];
#pragma unroll
        for (int e = 0; e < 32; ++e) o[e] = 0.f;
        for (int kk = -NMETA; kk <= tmax; ++kk) {
            const size_t krow = (kk < 0) ? (size_t)(NTOK + kk + NMETA) : (size_t)b * SEQ + kk;
            const int dist = (kk < 0) ? (16 + tq - (kk + NMETA)) : (tq - kk);
            const u32x4* kp = (const u32x4*)(P + krow * DIN + C_DK + h * 128 + m * 64);
            float s = 0.f;
#pragma unroll
            for (int d = 0; d < 8; ++d) { const u32x4 w = kp[d]; s += q[8*d] * bf2f(w.x & 0xffff) + q[8*d+1] * bf2f(w.x >> 16) + q[8*d+2] * bf2f(w.y & 0xffff) + q[8*d+3] * bf2f(w.y >> 16) + q[8*d+4] * bf2f(w.z & 0xffff) + q[8*d+5] * bf2f(w.z >> 16) + q[8*d+6] * bf2f(w.w & 0xffff) + q[8*d+7] * bf2f(w.w >> 16); }
            s += bias[dist < 127 ? (dist < 0 ? 0 : dist) : 127];
            if (dist >= 0) {
                const float mn = fmaxf(mr, s), al = exp2f(mr - mn), pe = exp2f(s - mn);
                const u32x4* vp = (const u32x4*)(P + krow * DIN + C_DV + h * 128 + ch * 32);
                l = l * al + pe;
#pragma unroll
                for (int e = 0; e < 4; ++e) { const u32x4 w = vp[e]; const unsigned ww[4] = {w.x, w.y, w.z, w.w};
#pragma unroll
                    for (int i = 0; i < 4; ++i) { o[8*e+2*i] = o[8*e+2*i] * al + pe * bf2f(ww[i] & 0xffff); o[8*e+2*i+1] = o[8*e+2*i+1] * al + pe * bf2f(ww[i] >> 16); } }
                mr = mn;
            }
        }
        const float il = 1.f / l;
#pragma unroll
        for (int e = 0; e < 32; ++e) on[m][e] = o[e] * il;
    }
    const float lam = sm[SM_LAM];
    float ss = 0.f, r[32];
#pragma unroll
    for (int e = 0; e < 32; ++e) { r[e] = on[0][e] - lam * on[1][e]; ss += r[e] * r[e]; }
    ss += __shfl_xor(ss, 1); ss += __shfl_xor(ss, 2);
    const float rstd = 1.f / sqrtf(ss * (1.f / 128.f) + EPS) * 0.8f;
    bf16* op = mix + (size_t)tok * D + h * 128 + ch * 32;
#pragma unroll
    for (int e = 0; e < 32; e += 2) *(unsigned*)(op + e) = pk2(r[e] * rstd * p.subg[ch * 32 + e], r[e + 1] * rstd * p.subg[ch * 32 + e + 1]);
}

__global__ void __launch_bounds__(64) k_attn_swa(Ptrs p) {
    const bf16* P = (const bf16*)(p.ws + WS_R1); bf16* mix = (bf16*)(p.ws + WS_R2); const float* sm = (const float*)(p.ws + WS_SM);
    const int tok = blockIdx.x * 64 + threadIdx.x, hq = blockIdx.y, kv = hq >> 2;
    const int b = tok / SEQ, tq = tok % SEQ;
    const float* bias = sm + SM_BIASS + hq * 128;
    float q[64];
    { const u32x4* qp = (const u32x4*)(P + (size_t)tok * DIN + C_SQ + hq * 64);
#pragma unroll
      for (int d = 0; d < 8; ++d) { const u32x4 w = qp[d]; q[8*d] = bf2f(w.x & 0xffff); q[8*d+1] = bf2f(w.x >> 16); q[8*d+2] = bf2f(w.y & 0xffff); q[8*d+3] = bf2f(w.y >> 16); q[8*d+4] = bf2f(w.z & 0xffff); q[8*d+5] = bf2f(w.z >> 16); q[8*d+6] = bf2f(w.w & 0xffff); q[8*d+7] = bf2f(w.w >> 16); } }
    float mr = p.sinks[hq] * LOG2E, l = 1.f, o[64];
#pragma unroll
    for (int e = 0; e < 64; ++e) o[e] = 0.f;
    for (int i = 0; i < NMETA + 128; ++i) {
        int kk, dist; size_t krow;
        if (i < NMETA) { kk = i; krow = (size_t)NTOK + i; dist = 16 + tq - i; }
        else { kk = tq - 127 + (i - NMETA); krow = (size_t)b * SEQ + kk; dist = tq - kk; if (kk < 0) continue; }
        const u32x4* kp = (const u32x4*)(P + krow * DIN + C_SK + kv * 64);
        float s = 0.f;
#pragma unroll
        for (int d = 0; d < 8; ++d) { const u32x4 w = kp[d]; s += q[8*d] * bf2f(w.x & 0xffff) + q[8*d+1] * bf2f(w.x >> 16) + q[8*d+2] * bf2f(w.y & 0xffff) + q[8*d+3] * bf2f(w.y >> 16) + q[8*d+4] * bf2f(w.z & 0xffff) + q[8*d+5] * bf2f(w.z >> 16) + q[8*d+6] * bf2f(w.w & 0xffff) + q[8*d+7] * bf2f(w.w >> 16); }
        s += bias[dist < 127 ? dist : 127];
        const float mn = fmaxf(mr, s), al = exp2f(mr - mn), pe = exp2f(s - mn);
        const u32x4* vp = (const u32x4*)(P + krow * DIN + C_SV + kv * 64);
        l = l * al + pe;
#pragma unroll
        for (int e = 0; e < 8; ++e) { const u32x4 w = vp[e]; const unsigned ww[4] = {w.x, w.y, w.z, w.w};
#pragma unroll
            for (int i = 0; i < 4; ++i) { o[8*e+2*i] = o[8*e+2*i] * al + pe * bf2f(ww[i] & 0xffff); o[8*e+2*i+1] = o[8*e+2*i+1] * al + pe * bf2f(ww[i] >> 16); } }
        mr = mn;
    }
    const float il = 1.f / l;
    bf16* op = mix + (size_t)tok * D + 512 + hq * 64;
#pragma unroll
    for (int e = 0; e < 64; e += 2) *(unsigned*)(op + e) = pk2(o[e] * il, o[e + 1] * il);
}

__global__ void __launch_bounds__(256) k_router(Ptrs p) {
    const int lane = threadIdx.x & 63, tok = blockIdx.x * 4 + (threadIdx.x >> 6);
    unsigned* ctl = (unsigned*)(p.ws + WS_CTL);
    const f32x4* hr = (const f32x4*)(p.out + (size_t)tok * D) + lane;
    float t[16]; float s = 0.f;
#pragma unroll
    for (int j = 0; j < 4; ++j) { const f32x4 v = hr[64 * j]; t[4 * j] = v.x; t[4 * j + 1] = v.y; t[4 * j + 2] = v.z; t[4 * j + 3] = v.w; s += (v.x * v.x + v.y * v.y) + (v.z * v.z + v.w * v.w); }
    const float rstd = 1.f / sqrtf(wave_sum(s) * (1.f / D) + EPS);
#pragma unroll
    for (int j = 0; j < 4; ++j) { const f32x4 g = ((const f32x4*)p.g2)[lane + 64 * j]; t[4 * j] *= rstd * g.x; t[4 * j + 1] *= rstd * g.y; t[4 * j + 2] *= rstd * g.z; t[4 * j + 3] *= rstd * g.w; }
    float gl[4];
#pragma unroll
    for (int c = 0; c < 4; ++c) { float a = 0.f;
#pragma unroll
        for (int j = 0; j < 4; ++j)
#pragma unroll
            for (int i = 0; i < 4; ++i) a += t[4 * j + i] * p.w_group[(size_t)(256 * j + 4 * lane + i) * 4 + c];
        gl[c] = wave_sum(a) + p.b_group[c]; }
    int g = 0; float gm = gl[0];
#pragma unroll
    for (int c = 1; c < 4; ++c) if (gl[c] > gm) { gm = gl[c]; g = c; }
    float den = 0.f;
#pragma unroll
    for (int c = 0; c < 4; ++c) den += expf(gl[c] - gm);
    const float g_w = 1.f / den;
    float el[8];
#pragma unroll
    for (int c = 0; c < 8; ++c) { float a = 0.f;
#pragma unroll
        for (int j = 0; j < 4; ++j)
#pragma unroll
            for (int i = 0; i < 4; ++i) a += t[4 * j + i] * p.w_router[(size_t)(256 * j + 4 * lane + i) * 32 + g * 8 + c];
        el[c] = wave_sum(a) + p.b_router[g * 8 + c]; }
    int j0 = 0; float l0 = el[0];
#pragma unroll
    for (int c = 1; c < 8; ++c) if (el[c] > l0) { l0 = el[c]; j0 = c; }
    int j1 = -1; float l1 = -3.0e38f;
#pragma unroll
    for (int c = 0; c < 8; ++c) if (c != j0 && el[c] > l1) { l1 = el[c]; j1 = c; }
    const float e1 = expf(l1 - l0), ga = g_w / (1.f + e1), gb = g_w * e1 / (1.f + e1);
    if (lane == 0) {
        const int ea = g * 8 + j0, eb = g * 8 + j1;
        const unsigned pa = atomicAdd(&ctl[CW_CNT + 64 * ea], 1u), pb = atomicAdd(&ctl[CW_CNT + 64 * eb], 1u);
        unsigned* ep = (unsigned*)(p.ws + WS_TOK + TOK_EP); float* gt = (float*)(p.ws + WS_TOK + TOK_GATE);
        ep[2 * tok] = ((unsigned)ea << 20) | pa; ep[2 * tok + 1] = ((unsigned)eb << 20) | pb; gt[2 * tok] = ga; gt[2 * tok + 1] = gb;
    }
}

__device__ __forceinline__ int pstart_of(const unsigned* ctl, int e) { int s = 0; for (int i = 0; i < e; ++i) s += (int)((ctl[CW_CNT + 64 * i] + 255u) >> 8) << 8; return s; }

__global__ void __launch_bounds__(256) k_permute(Ptrs p) {
    __shared__ int ps[NEXP + 1];
    const unsigned* ctl = (const unsigned*)(p.ws + WS_CTL);
    if (threadIdx.x == 0) { int s = 0; for (int e = 0; e < NEXP; ++e) { ps[e] = s; s += (int)((ctl[CW_CNT + 64 * e] + 255u) >> 8) << 8; } ps[NEXP] = s; }
    __syncthreads();
    if (blockIdx.x == 0) { int* te = (int*)(p.ws + WS_TOK + TOK_TILEE); for (int e = threadIdx.x; e < NEXP; e += 256) for (int t = ps[e] >> 8; t < (ps[e + 1] >> 8); ++t) te[t] = e;
        if (threadIdx.x == 0) *(int*)(p.ws + WS_TOK + TOK_NT) = ps[NEXP] >> 8; }
    const int lane = threadIdx.x & 63, tok = blockIdx.x * 4 + (threadIdx.x >> 6);
    const f32x4* hr = (const f32x4*)(p.out + (size_t)tok * D) + lane;
    f32x4 v[4]; float s = 0.f;
#pragma unroll
    for (int j = 0; j < 4; ++j) { v[j] = hr[64 * j]; s += (v[j].x * v[j].x + v[j].y * v[j].y) + (v[j].z * v[j].z + v[j].w * v[j].w); }
    const float rstd = 1.f / sqrtf(wave_sum(s) * (1.f / D) + EPS);
    const unsigned* ep = (const unsigned*)(p.ws + WS_TOK + TOK_EP); const float* gt = (const float*)(p.ws + WS_TOK + TOK_GATE);
    bf16* Xs = (bf16*)(p.ws + WS_R1); float* gs = (float*)(p.ws + WS_TOK + TOK_GSLOT);
    u32x2 w[4];
#pragma unroll
    for (int j = 0; j < 4; ++j) { const f32x4 g = ((const f32x4*)p.g2)[lane + 64 * j]; w[j] = (u32x2){pk2(v[j].x * rstd * g.x, v[j].y * rstd * g.y), pk2(v[j].z * rstd * g.z, v[j].w * rstd * g.w)}; }
#pragma unroll
    for (int k = 0; k < 2; ++k) { const unsigned r = ep[2 * tok + k]; const int slot = ps[r >> 20] + (int)(r & 0xfffffu);
        u32x2* o8 = (u32x2*)(Xs + (size_t)slot * D) + lane;
#pragma unroll
        for (int j = 0; j < 4; ++j) o8[64 * j] = w[j];
        if (lane == 0) gs[slot] = gt[2 * tok + k]; }
}

__global__ void __launch_bounds__(256) k_combine(Ptrs p) {
    __shared__ int ps[NEXP + 1];
    const unsigned* ctl = (const unsigned*)(p.ws + WS_CTL);
    if (threadIdx.x == 0) { int s = 0; for (int e = 0; e < NEXP; ++e) { ps[e] = s; s += (int)((ctl[CW_CNT + 64 * e] + 255u) >> 8) << 8; } ps[NEXP] = s; }
    __syncthreads();
    const int lane = threadIdx.x & 63, tok = blockIdx.x * 4 + (threadIdx.x >> 6);
    const unsigned* ep = (const unsigned*)(p.ws + WS_TOK + TOK_EP); const bf16* Y = (const bf16*)(p.ws + WS_R1);
    const unsigned r0 = ep[2 * tok], r1 = ep[2 * tok + 1];
    const int s0 = ps[r0 >> 20] + (int)(r0 & 0xfffffu), s1 = ps[r1 >> 20] + (int)(r1 & 0xfffffu);
    f32x4* hr = (f32x4*)(p.out + (size_t)tok * D) + lane;
    const u32x2* y0 = (const u32x2*)(Y + (size_t)s0 * D) + lane; const u32x2* y1 = (const u32x2*)(Y + (size_t)s1 * D) + lane;
#pragma unroll
    for (int j = 0; j < 4; ++j) { f32x4 v = hr[64 * j]; const u32x2 a = y0[64 * j], b = y1[64 * j];
        v.x += bf2f(a.x & 0xffff) + bf2f(b.x & 0xffff); v.y += bf2f(a.x >> 16) + bf2f(b.x >> 16); v.z += bf2f(a.y & 0xffff) + bf2f(b.y & 0xffff); v.w += bf2f(a.y >> 16) + bf2f(b.y >> 16);
        hr[64 * j] = v; }
}

extern "C" void kernel_launch(void* const* d_in, const int* in_sizes, int n_in, void* d_out, int out_size, void* d_ws, size_t ws_size, hipStream_t stream) {
    if (n_in != 24 || in_sizes[0] != NTOK * D || out_size != NTOK * D || ws_size < WS_END) { fprintf(stderr, "kernel_launch: unexpected shapes (n_in %d, in0 %d, out %d, ws %zu)\n", n_in, n_in > 0 ? in_sizes[0] : -1, out_size, ws_size); return; }
    Ptrs p{};
    const float** f = (const float**)&p;
    for (int i = 0; i < 24; ++i) f[i] = (const float*)d_in[i];
    p.out = (float*)d_out; p.ws = (unsigned char*)d_ws;
    hipMemsetAsync((char*)d_ws + WS_CTL, 0, CTL_ZERO_BYTES, stream);
    k_convert<<<1024, 256, 0, stream>>>(p);
    k_gemm<0><<<dim3(DIN / 64, MROWS / 64), 256, 0, stream>>>(p, D);
    k_attn_diff<<<dim3(NTOK / 16, 4), 64, 0, stream>>>(p);
    k_attn_swa<<<dim3(NTOK / 64, 8), 64, 0, stream>>>(p);
    k_gemm<1><<<dim3(D / 64, NTOK / 64), 256, 0, stream>>>(p, D);
    k_router<<<NTOK / 4, 256, 0, stream>>>(p);
    k_permute<<<NTOK / 4, 256, 0, stream>>>(p);
    k_gemm<2><<<dim3(DEXP / 64, MAXSLOT / 64), 256, 0, stream>>>(p, D);
    k_gemm<3><<<dim3(D / 64, MAXSLOT / 64), 256, 0, stream>>>(p, DEXP);
    k_combine<<<NTOK / 4, 256, 0, stream>>>(p);
}
```

```cpp
#include <hip/hip_runtime.h>
#include <cstdio>
#include <cstdint>

typedef unsigned short bf16;
typedef unsigned u32x4 __attribute__((ext_vector_type(4)));
typedef unsigned u32x2 __attribute__((ext_vector_type(2)));
typedef float f32x4 __attribute__((ext_vector_type(4)));

constexpr int NB = 4, SEQ = 4096, D = 1024, NTOK = NB * SEQ, NMETA = 16;
constexpr int MROWS = NTOK + 256;
constexpr int DIN = 2304;
constexpr int C_DQ = 0, C_DK = 512, C_DV = 1024, C_SQ = 1536, C_SK = 2048, C_SV = 2176;
constexpr int NEXP = 32, DEXP = 512;
constexpr int MAXSLOT = 40960;
constexpr float EPS = 1e-6f;
constexpr float LOG2E = 1.4426950408889634f;
constexpr float C2 = 0.125f * LOG2E;

constexpr size_t MiB = 1u << 20;
constexpr size_t WS_CTL = 0, CTL_ZERO_BYTES = 1 * MiB;
constexpr size_t WS_SM = 1 * MiB;
constexpr size_t WS_TOK = 2 * MiB;
constexpr size_t WS_WIN = 4 * MiB, WS_WOUT = 9 * MiB, WS_WGU = 12 * MiB, WS_WD = 76 * MiB;
constexpr size_t WS_R1 = 108 * MiB;
constexpr size_t WS_R2 = 188 * MiB;
constexpr size_t WS_END = 228 * MiB;
constexpr int CW_BAR = 4096;
constexpr int CW_CNT = 16384;
constexpr int SM_BIASD = 0, SM_BIASS = 512, SM_LAM = 1536;
constexpr size_t TOK_EP = 0, TOK_GATE = 131072, TOK_GSLOT = 262144, TOK_TILEE = 262144 + 163840, TOK_NT = TOK_TILEE + 1024;

__device__ __forceinline__ float bf2f(bf16 v) { return __builtin_bit_cast(float, (unsigned)v << 16); }
__device__ __forceinline__ unsigned f2bf(float f) { unsigned u = __builtin_bit_cast(unsigned, f); return (u + 0x7fffu + ((u >> 16) & 1u)) >> 16; }
__device__ __forceinline__ unsigned pk2(float lo, float hi) { return f2bf(lo) | (f2bf(hi) << 16); }
__device__ __forceinline__ float wave_sum(float v) {
#pragma unroll
    for (int o = 1; o < 64; o <<= 1) v += __shfl_xor(v, o);
    return v;
}
__device__ __forceinline__ int t5_bucket(int n) {
    if (n < 16) return n;
    const int st[16] = {16, 19, 21, 24, 27, 31, 35, 40, 46, 52, 59, 67, 77, 87, 99, 113};
    int b = 15;
#pragma unroll
    for (int i = 0; i < 16; ++i) b += (n >= st[i]) ? 1 : 0;
    return b;
}
__host__ __device__ __forceinline__ int win_row_of_col(int c) { const int T = c >> 8, r = c & 255, wc = r >> 6, bj = (r >> 5) & 1, i = r & 31; return T * 256 + bj * 128 + wc * 32 + i; }

struct Ptrs {
    const float *x, *meta, *rel_bias, *g1, *w_in, *dqg, *dkg, *lq1, *lk1, *lq2, *lk2, *subg, *sqg, *skg, *sinks, *w_out, *g2, *w_group, *b_group, *w_router, *b_router, *w_gate, *w_up, *w_down;
    float* out; unsigned char* ws;
};

#define LAS __attribute__((address_space(3)))
__device__ __forceinline__ void transpose_item(const float* W, int K, int N, bf16* WT, int k0, int n0, int drow0, float* scr, int lane) {
#pragma unroll 8
    for (int i = 0; i < 32; ++i) { const int kk = 2 * i + (lane >> 5); scr[kk * 33 + (lane & 31)] = W[(size_t)(k0 + kk) * N + n0 + (lane & 31)]; }
    asm volatile("s_waitcnt lgkmcnt(0)" ::: "memory");
    const int c = lane & 7;
#pragma unroll
    for (int j = 0; j < 4; ++j) { const int n = (lane >> 3) + 8 * j; const float* s = scr + (8 * c) * 33 + n;
        u32x4 o; o.x = pk2(s[0 * 33], s[1 * 33]); o.y = pk2(s[2 * 33], s[3 * 33]); o.z = pk2(s[4 * 33], s[5 * 33]); o.w = pk2(s[6 * 33], s[7 * 33]);
        *(u32x4*)(WT + (size_t)(drow0 + n) * K + k0 + 8 * c) = o; }
    asm volatile("s_waitcnt lgkmcnt(0)" ::: "memory");
}


namespace pg8 {
#define PG8_LAS __attribute__((address_space(3)))
typedef unsigned short bf16_t;
typedef short bf16x8 __attribute__((ext_vector_type(8)));
typedef float f32x4 __attribute__((ext_vector_type(4)));
typedef unsigned u32x4 __attribute__((ext_vector_type(4)));
constexpr int BM = 256, BK = 64, HALF = 128, HTB = HALF * BK * 2  , STAGE_BYTES = 8 * HTB, NXCD = 8, WGM = 8;

__host__ __device__ __forceinline__ int lds_byte(int r, int c) { const int st = (r >> 4) * 2 + (c >> 5), rr = r & 15, cc = c & 31, ob = rr * 64 + cc * 2; return st * 1024 + (ob ^ (((ob >> 9) & 1) << 5)); }
__host__ __device__ __forceinline__ void stage_rc(int b, int& R, int& C) { const int st = b / 1024, sb = b % 1024, swz = sb ^ (((sb >> 9) & 1) << 5); R = (st >> 1) * 16 + swz / 64; C = (st & 1) * 32 + (swz % 64) / 2; }
__host__ __device__ __forceinline__ int perm32(int rho) { const int n = rho >> 4, i = rho & 15; return 8 * (i >> 2) + 4 * n + (i & 3); }

struct Unit { int pm, pn; };
struct Gemm { const bf16_t* A; const bf16_t* Bt; int M, N, K; };

struct StaticOrder {
    int nM, nN, nwg, G, c;
    __host__ __device__ void init(int M, int N, int G_, int c_) { nM = M / BM; nN = N / BM; nwg = nM * nN; G = G_; c = c_; }
    __host__ __device__ bool next(int i, Unit& u) const {
        const long L = (long)i * G + c; if (L >= nwg) return false;
        int wgid = (int)L; { const int q = nwg / NXCD, r = nwg % NXCD, xcd = wgid % NXCD, off = wgid / NXCD; wgid = (xcd < r ? xcd * (q + 1) : r * (q + 1) + (xcd - r) * q) + off; }
        const int nig = WGM * nN, gid = wgid / nig, fm = gid * WGM, gsz = (nM - fm) < WGM ? (nM - fm) : WGM;
        u.pm = fm + ((wgid % nig) % gsz); u.pn = (wgid % nig) / gsz; return true;
    }
    __device__ __forceinline__ void a_ready(const Unit&) const {}
    __device__ __forceinline__ void done(const Unit&) const {}
};


__device__ __forceinline__ unsigned cvt_pk_bf16(float lo, float hi) { unsigned r; asm volatile("v_cvt_pk_bf16_f32 %0, %1, %2" : "=v"(r) : "v"(lo), "v"(hi)); return r; }
__device__ __forceinline__ u32x4 pack8(const f32x4 a, const f32x4 b) { u32x4 w; w.x = cvt_pk_bf16(a[0], a[1]); w.y = cvt_pk_bf16(a[2], a[3]); w.z = cvt_pk_bf16(b[0], b[1]); w.w = cvt_pk_bf16(b[2], b[3]); return w; }

struct EpiProj {
    static constexpr bool PERM = true, AFTER_DRAIN = false;
    bf16_t* P; const float *dqg, *dkg, *sqg, *skg;
    __device__ __forceinline__ void operator()(const f32x4 (&acc)[2][2][4][2], const Unit& u, int wr, int wc, int fr, int fq) const {
        const int chunk = u.pn * 4 + wc;
        bool kind = false; const float* gain = dqg; float sc = 1.f;
        if (chunk < 8) { kind = true; gain = dqg; sc = C2; } else if (chunk < 16) { kind = true; gain = dkg; } else if (chunk < 24) { kind = false; }
        else if (chunk < 32) { kind = true; gain = sqg; sc = C2; } else if (chunk < 34) { kind = true; gain = skg; }
        f32x4 gv[2][2];
#pragma unroll
        for (int bj = 0; bj < 2; ++bj)
#pragma unroll
            for (int n = 0; n < 2; ++n) gv[bj][n] = kind ? *(const f32x4*)(gain + 32 * bj + 8 * fq + 4 * n) * sc : (f32x4){1.f, 1.f, 1.f, 1.f};
        const int row0 = u.pm * BM + wr * 64 + fr, col0 = u.pn * BM + 64 * wc + 8 * fq;
#pragma unroll
        for (int ai = 0; ai < 2; ++ai)
#pragma unroll
            for (int m = 0; m < 4; ++m) {
                float ss = 0.f;
#pragma unroll
                for (int bj = 0; bj < 2; ++bj)
#pragma unroll
                    for (int n = 0; n < 2; ++n) { const f32x4 v = acc[ai][bj][m][n]; ss += (v[0] * v[0] + v[1] * v[1]) + (v[2] * v[2] + v[3] * v[3]); }
                ss += __shfl_xor(ss, 16); ss += __shfl_xor(ss, 32);
                const float rstd = kind ? 1.f / sqrtf(ss * (1.f / 64.f) + EPS) : 1.f;
                bf16_t* rowp = P + (size_t)(row0 + ai * HALF + m * 16) * DIN + col0;
#pragma unroll
                for (int bj = 0; bj < 2; ++bj) *(u32x4*)(rowp + 32 * bj) = pack8(acc[ai][bj][m][0] * gv[bj][0] * rstd, acc[ai][bj][m][1] * gv[bj][1] * rstd);
            }
    }
};
struct EpiOut {
    static constexpr bool PERM = true, AFTER_DRAIN = false;
    const float* x; float* out;
    __device__ __forceinline__ void operator()(const f32x4 (&acc)[2][2][4][2], const Unit& u, int wr, int wc, int fr, int fq) const {
        const int row0 = u.pm * BM + wr * 64 + fr, col0 = u.pn * BM + wc * 32 + 8 * fq;
#pragma unroll
        for (int ai = 0; ai < 2; ++ai)
#pragma unroll
            for (int m = 0; m < 4; ++m)
#pragma unroll
                for (int bj = 0; bj < 2; ++bj) { const size_t o = (size_t)(row0 + ai * HALF + m * 16) * D + col0 + bj * HALF;
                    const f32x4 x0 = *(const f32x4*)(x + o), x1 = *(const f32x4*)(x + o + 4);
                    *(f32x4*)(out + o) = x0 + acc[ai][bj][m][0]; *(f32x4*)(out + o + 4) = x1 + acc[ai][bj][m][1]; }
    }
};
struct EpiGU {
    static constexpr bool PERM = true, AFTER_DRAIN = false;
    bf16_t* H;
    __device__ __forceinline__ void operator()(const f32x4 (&acc)[2][2][4][2], const Unit& u, int wr, int wc, int fr, int fq) const {
        const int pnl = u.pn & 3, row0 = u.pm * BM + wr * 64 + fr, col0 = pnl * 128 + wc * 32 + 8 * fq;
#pragma unroll
        for (int ai = 0; ai < 2; ++ai)
#pragma unroll
            for (int m = 0; m < 4; ++m) { f32x4 v[2];
#pragma unroll
                for (int n = 0; n < 2; ++n)
#pragma unroll
                    for (int i = 0; i < 4; ++i) { const float g = acc[ai][0][m][n][i]; v[n][i] = g * __builtin_amdgcn_rcpf(1.f + __builtin_amdgcn_exp2f(-LOG2E * g)) * acc[ai][1][m][n][i]; }
                *(u32x4*)(H + (size_t)(row0 + ai * HALF + m * 16) * DEXP + col0) = pack8(v[0], v[1]); }
    }
};
struct EpiDown {
    static constexpr bool PERM = true, AFTER_DRAIN = false;
    bf16_t* Y; const float* gs;
    __device__ __forceinline__ void operator()(const f32x4 (&acc)[2][2][4][2], const Unit& u, int wr, int wc, int fr, int fq) const {
        const int pnl = u.pn & 3, row0 = u.pm * BM + wr * 64 + fr, col0 = pnl * BM + wc * 32 + 8 * fq;
#pragma unroll
        for (int ai = 0; ai < 2; ++ai)
#pragma unroll
            for (int m = 0; m < 4; ++m) { const int r = row0 + ai * HALF + m * 16; const float g = gs[r];
#pragma unroll
                for (int bj = 0; bj < 2; ++bj) *(u32x4*)(Y + (size_t)r * D + col0 + bj * HALF) = pack8(acc[ai][bj][m][0] * g, acc[ai][bj][m][1] * g); }
    }
};
struct MoeOrder {
    StaticOrder so; const PG8_LAS int* tile_e;
    __device__ __forceinline__ bool next(int i, Unit& u) const { if (!so.next(i, u)) return false; u.pn += 4 * tile_e[u.pm]; return true; }
    __device__ __forceinline__ void a_ready(const Unit&) const {}
    __device__ __forceinline__ void done(const Unit&) const {}
};

template <class Epi, class Sched, bool ALIGN_EPI = false, bool SP2 = false>
__device__ __forceinline__ void gemm_phase(PG8_LAS unsigned char* lds, const Gemm g, const Sched& S, const Epi& E) {
    const int tid = threadIdx.x, wid = __builtin_amdgcn_readfirstlane(tid >> 6), lane = tid & 63, wr = wid >> 2, wc = wid & 3, fr = lane & 15, fq = lane >> 4;
    const int K = g.K, nt = K / BK;
    unsigned voffA[2], voffB[2];
#pragma unroll
    for (int i = 0; i < 2; ++i) { int R, C; stage_rc(tid * 16 + i * 8192, R, C); const int Rb = Epi::PERM ? ((R & ~31) + perm32(R & 31)) : R;
        voffA[i] = (unsigned)(R * K + C) * 2u; voffB[i] = (unsigned)(Rb * K + C) * 2u; }
    const size_t kstep = (size_t)(BK * 2);
    const size_t hstep = (size_t)HALF * K * 2;
    const size_t tstep = 2 * hstep;
    const unsigned ldsw = (unsigned)wid * 1024u;
    const int aoff = lds_byte(wr * 64 + fr, fq * 8), boff = lds_byte(wc * 32 + fr, fq * 8);
#define PG8_SA(b, h) (((b) * 2 + (h)) * HTB)
#define PG8_SB(b, h) ((4 + (b) * 2 + (h)) * HTB)
#define PG8_STAGE(bufoff, gbase, voff) do { _Pragma("unroll") for (int _i = 0; _i < 2; ++_i) \
        __builtin_amdgcn_global_load_lds((const unsigned*)((const char*)(gbase) + (voff)[_i]), (PG8_LAS unsigned*)(lds + (bufoff) + ldsw + _i * 8192), 16, 0, 0); } while (0)
#define PG8_LDA(dst, b, h) do { _Pragma("unroll") for (int m = 0; m < 4; ++m) _Pragma("unroll") for (int k = 0; k < 2; ++k) dst[m][k] = *(const PG8_LAS bf16x8*)(lds + PG8_SA(b, h) + aoff + m * 2048 + k * 1024); } while (0)
#define PG8_LDB(dst, b, h) do { _Pragma("unroll") for (int n = 0; n < 2; ++n) _Pragma("unroll") for (int k = 0; k < 2; ++k) dst[n][k] = *(const PG8_LAS bf16x8*)(lds + PG8_SB(b, h) + boff + n * 2048 + k * 1024); } while (0)
#define PG8_MMA(ai, bj, At, Bt) do { __builtin_amdgcn_s_setprio(1); _Pragma("unroll") for (int m = 0; m < 4; ++m) _Pragma("unroll") for (int n = 0; n < 2; ++n) _Pragma("unroll") for (int k = 0; k < 2; ++k) \
        acc[ai][bj][m][n] = __builtin_amdgcn_mfma_f32_16x16x32_bf16(Bt[n][k], At[m][k], acc[ai][bj][m][n], 0, 0, 0); __builtin_amdgcn_s_setprio(0); } while (0)
#define PG8_WAIT_V(n) asm volatile("s_waitcnt vmcnt(" #n ")" ::: "memory")
#define PG8_WAIT_L(n) asm volatile("s_waitcnt lgkmcnt(" #n ")" ::: "memory")
#define PG8_BAR __builtin_amdgcn_s_barrier()
#define PG8_SCHED __builtin_amdgcn_sched_barrier(0)
    Unit cur, nxt; int ui = 0;
    if (!S.next(0, cur)) return;
    f32x4 acc[2][2][4][2];
#pragma unroll
    for (int a = 0; a < 2; ++a)
#pragma unroll
        for (int b = 0; b < 2; ++b)
#pragma unroll
            for (int m = 0; m < 4; ++m)
#pragma unroll
                for (int n = 0; n < 2; ++n) acc[a][b][m][n] = (f32x4){0.f, 0.f, 0.f, 0.f};
    bf16x8 At[4][2], B0[2][2], B1[2][2];
    const char* cA = (const char*)g.A + (size_t)cur.pm * tstep; const char* cB = (const char*)g.Bt + (size_t)cur.pn * tstep;
    S.a_ready(cur);
    if constexpr (SP2) {
        PG8_STAGE(PG8_SB(0, 0), cB, voffB); PG8_STAGE(PG8_SB(0, 1), cB + hstep, voffB); PG8_STAGE(PG8_SA(0, 0), cA, voffA); PG8_STAGE(PG8_SA(0, 1), cA + hstep, voffA);
        if (wr == 1) PG8_BAR;
        PG8_WAIT_V(2); PG8_BAR;
        PG8_STAGE(PG8_SB(1, 0), cB + kstep, voffB); PG8_STAGE(PG8_SA(1, 0), cA + kstep, voffA); PG8_STAGE(PG8_SB(1, 1), cB + hstep + kstep, voffB);
        PG8_WAIT_V(6); PG8_BAR;
    } else {
        PG8_STAGE(PG8_SB(0, 0), cB, voffB); PG8_STAGE(PG8_SA(0, 0), cA, voffA); PG8_STAGE(PG8_SB(0, 1), cB + hstep, voffB); PG8_STAGE(PG8_SA(0, 1), cA + hstep, voffA);
        if (wr == 1) PG8_BAR;
        PG8_WAIT_V(4); PG8_BAR;
        PG8_STAGE(PG8_SB(1, 0), cB + kstep, voffB); PG8_STAGE(PG8_SA(1, 0), cA + kstep, voffA); PG8_STAGE(PG8_SB(1, 1), cB + hstep + kstep, voffB);
        PG8_WAIT_V(6); PG8_BAR;
    }
    for (;;) {
        const bool has_next = S.next(ui + 1, nxt);
        const char* nA = has_next ? (const char*)g.A + (size_t)nxt.pm * tstep : cA; const char* nB = has_next ? (const char*)g.Bt + (size_t)nxt.pn * tstep : cB;
        for (int t = 0; t < nt; t += 2) {
            const bool last = (t == nt - 2);
            const char* a1 = cA + (size_t)(t + 1) * kstep;
            const char* a2 = last ? nA : cA + (size_t)(t + 2) * kstep; const char* b2 = last ? nB : cB + (size_t)(t + 2) * kstep;
            const char* a3 = a2 + kstep; const char* b3 = b2 + kstep;
            if (last && has_next) S.a_ready(nxt);
            if constexpr (SP2) {
            PG8_LDB(B0, 0, 0); PG8_LDB(B1, 0, 1); PG8_SCHED; PG8_LDA(At, 0, 0); PG8_STAGE(PG8_SA(1, 1), a1 + hstep, voffA);
            PG8_WAIT_V(8); PG8_WAIT_L(0); PG8_BAR; PG8_MMA(0, 0, At, B0); PG8_MMA(0, 1, At, B1); PG8_BAR; PG8_SCHED;
            PG8_LDA(At, 0, 1); PG8_STAGE(PG8_SB(0, 0), b2, voffB); PG8_STAGE(PG8_SB(0, 1), b2 + hstep, voffB); PG8_STAGE(PG8_SA(0, 0), a2, voffA);
            PG8_WAIT_V(8); PG8_WAIT_L(0); PG8_BAR; PG8_MMA(1, 0, At, B0); PG8_MMA(1, 1, At, B1); PG8_BAR; PG8_SCHED;
            PG8_LDB(B0, 1, 0); PG8_LDB(B1, 1, 1); PG8_SCHED; PG8_LDA(At, 1, 0); PG8_STAGE(PG8_SA(0, 1), a2 + hstep, voffA);
            PG8_WAIT_V(8); PG8_WAIT_L(0); PG8_BAR; PG8_MMA(0, 0, At, B0); PG8_MMA(0, 1, At, B1); PG8_BAR; PG8_SCHED;
            PG8_LDA(At, 1, 1); PG8_STAGE(PG8_SB(1, 0), b3, voffB); PG8_STAGE(PG8_SB(1, 1), b3 + hstep, voffB); PG8_STAGE(PG8_SA(1, 0), a3, voffA);
            PG8_WAIT_V(8); PG8_WAIT_L(0); PG8_BAR; PG8_MMA(1, 0, At, B0); PG8_MMA(1, 1, At, B1); PG8_BAR; PG8_SCHED;
            } else {
            PG8_LDB(B0, 0, 0); PG8_SCHED; PG8_LDA(At, 0, 0); PG8_STAGE(PG8_SA(1, 1), a1 + hstep, voffA);
            PG8_WAIT_L(8); PG8_BAR; PG8_WAIT_L(0); PG8_MMA(0, 0, At, B0); PG8_BAR; PG8_SCHED;
            PG8_LDB(B1, 0, 1); PG8_STAGE(PG8_SB(0, 0), b2, voffB);
            PG8_BAR; PG8_WAIT_L(0); PG8_MMA(0, 1, At, B1); PG8_BAR;
            PG8_LDA(At, 0, 1); PG8_STAGE(PG8_SA(0, 0), a2, voffA);
            PG8_BAR; PG8_WAIT_L(0); PG8_MMA(1, 0, At, B0); PG8_BAR; PG8_SCHED;
            PG8_STAGE(PG8_SB(0, 1), b2 + hstep, voffB);
            PG8_WAIT_V(6); PG8_BAR; PG8_MMA(1, 1, At, B1); PG8_BAR;
            PG8_LDB(B0, 1, 0); PG8_SCHED; PG8_LDA(At, 1, 0); PG8_STAGE(PG8_SA(0, 1), a2 + hstep, voffA);
            PG8_WAIT_L(8); PG8_BAR; PG8_WAIT_L(0); PG8_MMA(0, 0, At, B0); PG8_BAR; PG8_SCHED;
            PG8_LDB(B1, 1, 1); PG8_STAGE(PG8_SB(1, 0), b3, voffB);
            PG8_BAR; PG8_WAIT_L(0); PG8_MMA(0, 1, At, B1); PG8_BAR;
            PG8_LDA(At, 1, 1); PG8_STAGE(PG8_SA(1, 0), a3, voffA);
            PG8_BAR; PG8_WAIT_L(0); PG8_MMA(1, 0, At, B0); PG8_BAR; PG8_SCHED;
            PG8_STAGE(PG8_SB(1, 1), b3 + hstep, voffB);
            PG8_WAIT_V(6); PG8_BAR; PG8_MMA(1, 1, At, B1); PG8_BAR;
            }
        }
        if constexpr (ALIGN_EPI) { if (wr == 0) PG8_BAR; }
        if constexpr (!Epi::AFTER_DRAIN) { E(acc, cur, wr, wc, fr, fq); S.done(cur); }
        if (!has_next) break;
#pragma unroll
        for (int a = 0; a < 2; ++a)
#pragma unroll
            for (int b = 0; b < 2; ++b)
#pragma unroll
                for (int m = 0; m < 4; ++m)
#pragma unroll
                    for (int n = 0; n < 2; ++n) acc[a][b][m][n] = (f32x4){0.f, 0.f, 0.f, 0.f};
        cur = nxt; cA = nA; cB = nB; ++ui;
        if constexpr (ALIGN_EPI) { if (wr == 1) PG8_BAR; }
    }
    PG8_WAIT_V(0);
    if constexpr (!ALIGN_EPI) { if (wr == 0) PG8_BAR; }
    PG8_BAR;
    if constexpr (Epi::AFTER_DRAIN) { E.fused(acc, cur, wr, wc, fr, fq, lds, wid, lane); S.done(cur); }
#undef PG8_SA
#undef PG8_SB
#undef PG8_STAGE
#undef PG8_LDA
#undef PG8_LDB
#undef PG8_MMA
#undef PG8_WAIT_V
#undef PG8_WAIT_L
#undef PG8_BAR
#undef PG8_SCHED
}
}

#define XB_TMO      128
#define XB_XCNT(j)  (256  + 64 * (j))
#define XB_XSUB(j)  (1280 + 64 * (j))
#define XB_XGEN(j)  (2304 + 64 * (j))
#define XB_TOP      3328
#define XB_TOPGEN   3392
#define XCD_BAR_WORDS 3456
#define XB_SPIN_CAP (1u << 18)

__device__ __forceinline__ unsigned xb_ld(unsigned* p)              { return __hip_atomic_load(p, __ATOMIC_RELAXED, __HIP_MEMORY_SCOPE_AGENT); }
__device__ __forceinline__ unsigned xb_add(unsigned* p, unsigned v) { return __hip_atomic_fetch_add(p, v, __ATOMIC_RELAXED, __HIP_MEMORY_SCOPE_AGENT); }
__device__ __forceinline__ unsigned xb_xcc_id() { return (unsigned)__builtin_amdgcn_s_getreg((3 << 11) | 20) & 0xFu; }
#define XB_SPIN(cond, bar) do { unsigned _sp = 0; while (cond) { __builtin_amdgcn_s_sleep(1); \
    if ((++_sp & 255u) == 0u) { if (xb_ld(&(bar)[XB_TMO])) break; if (_sp > XB_SPIN_CAP) { atomicAdd(&(bar)[XB_TMO], 1u); break; } } } } while (0)

struct XcdBarrier {
    unsigned* bar; unsigned x;
    volatile LAS unsigned* st;
};

__device__ __forceinline__ XcdBarrier xcd_barrier_post(unsigned* bar, volatile LAS unsigned* st) {
    XcdBarrier b; b.bar = bar; b.x = xb_xcc_id(); b.st = st;
    if (threadIdx.x == 0) (void)xb_add(&bar[XB_XCNT(b.x)], 1u);
    return b;
}
__device__ __forceinline__ void xcd_barrier_complete(unsigned* bar, unsigned x, unsigned& nloc, unsigned& nx) {
    const unsigned G = gridDim.x * gridDim.y * gridDim.z;
    unsigned sum, cnt, mine, sp = 0u;
    for (;;) {
        sum = 0u; cnt = 0u; mine = 0u;
#pragma unroll
        for (unsigned j = 0; j < 16; ++j) { const unsigned c = xb_ld(&bar[XB_XCNT(j)]); sum += c; cnt += (c > 0u) ? 1u : 0u; mine = (j == x) ? c : mine; }
        if (sum == G) break;
        __builtin_amdgcn_s_sleep(1);
        if ((++sp & 255u) == 0u) { if (xb_ld(&bar[XB_TMO])) break; if (sp > XB_SPIN_CAP) { atomicAdd(&bar[XB_TMO], 1u); break; } }
    }
    nloc = mine > 0u ? mine : 1u; nx = cnt > 0u ? cnt : 1u;
}

__device__ __forceinline__ void xcd_barrier(const XcdBarrier& b) {
    asm volatile("s_waitcnt vmcnt(0)" ::: "memory");
    __syncthreads();
    if (threadIdx.x == 0) {
        unsigned* bar = b.bar;
        __builtin_amdgcn_s_waitcnt(0);
        unsigned nloc = b.st[0], nx = b.st[1];
        if (nloc == 0u) { xcd_barrier_complete(bar, b.x, nloc, nx); b.st[0] = nloc; b.st[1] = nx; }
        const unsigned old = xb_add(&bar[XB_XSUB(b.x)], 1u);
        const unsigned gen = old / nloc;
        if (old + 1u == (gen + 1u) * nloc) {
            __builtin_amdgcn_fence(__ATOMIC_RELEASE, "agent");
            asm volatile("s_waitcnt vmcnt(0)" ::: "memory");
            const unsigned og = xb_add(&bar[XB_TOP], 1u);
            const unsigned tg = og / nx;
            if (og + 1u == (tg + 1u) * nx) xb_add(&bar[XB_TOPGEN], 1u);
            else XB_SPIN(xb_ld(&bar[XB_TOPGEN]) == tg, bar);
            __builtin_amdgcn_fence(__ATOMIC_ACQUIRE, "agent");
            xb_add(&bar[XB_XGEN(b.x)], 1u);
            asm volatile("s_waitcnt vmcnt(0)" ::: "memory");
        } else {
            XB_SPIN(xb_ld(&bar[XB_XGEN(b.x)]) == gen, bar);
            __builtin_amdgcn_fence(__ATOMIC_ACQUIRE, "agent");
            asm volatile("s_waitcnt vmcnt(0)" ::: "memory");
        }
    }
    __syncthreads();
}

constexpr int NWAVES = 8;
constexpr int RING_BYTES = 131072, LDSCTL_OFF = RING_BYTES, MISC_OFF = LDSCTL_OFF + 320, TILEE_OFF = LDSCTL_OFF + 1024, PS_OFF = LDSCTL_OFF + 2048;
constexpr int LDS_BYTES = 147456;
constexpr int NPHASE = 9;

struct Frame {
    LAS unsigned char* lds; volatile LAS unsigned* MISC; unsigned* ctl;
    int tid, lane, wave, vcu, G;
};

__device__ __forceinline__ void moe_tables(Frame& F) {
    LAS int* ps = (LAS int*)(F.lds + PS_OFF); LAS int* te = (LAS int*)(F.lds + TILEE_OFF);
    if (F.wave == 0) {
        const int e = F.lane & 31;
        const int nt = (int)((__hip_atomic_load(F.ctl + CW_CNT + 64 * e, __ATOMIC_RELAXED, __HIP_MEMORY_SCOPE_AGENT) + 255u) >> 8);
        int inc = nt;
#pragma unroll
        for (int o = 1; o < 32; o <<= 1) { const int v = __shfl_up(inc, o, 32); if (e >= o) inc += v; }
        if (F.lane < 32) { ps[e] = inc - nt; if (e == 31) ps[32] = inc; for (int t = inc - nt; t < inc; ++t) te[t] = e; }
    }
    __syncthreads();
}

__device__ __forceinline__ void p0_prologue(Frame& F, const Ptrs& p) {
    float* scr = (float*)(F.lds + F.wave * 8704);
    const int lane = F.lane;
    const int gw = F.vcu * NWAVES + F.wave, NGW = F.G * NWAVES;
    bf16* Wt_in = (bf16*)(p.ws + WS_WIN); bf16* Wt_out = (bf16*)(p.ws + WS_WOUT); bf16* Wgu = (bf16*)(p.ws + WS_WGU); bf16* Wd = (bf16*)(p.ws + WS_WD);
    constexpr int I_IN = (D / 64) * (DIN / 32), I_OUT = (D / 64) * (D / 32), I_G = (D / 64) * (DEXP / 32), I_DN = (DEXP / 64) * (D / 32);
    constexpr int NITEMS = I_IN + I_OUT + NEXP * (2 * I_G + I_DN);
    for (int it = gw; it < NITEMS; it += NGW) {
        int r = it;
        if (r < I_IN) { const int nblk = DIN / 32, kb = r / nblk, nb = r % nblk; transpose_item(p.w_in, D, DIN, Wt_in, 64 * kb, 32 * nb, win_row_of_col(32 * nb), scr, lane); continue; } r -= I_IN;
        if (r < I_OUT) { const int nblk = D / 32, kb = r / nblk, nb = r % nblk; transpose_item(p.w_out, D, D, Wt_out, 64 * kb, 32 * nb, 32 * nb, scr, lane); continue; } r -= I_OUT;
        const int e = r / (2 * I_G + I_DN); r -= e * (2 * I_G + I_DN);
        if (r < 2 * I_G) { const int up = r / I_G; r -= up * I_G; const int nblk = DEXP / 32, kb = r / nblk, nb = r % nblk; const int c0 = 32 * nb;
            transpose_item((up ? p.w_up : p.w_gate) + (size_t)e * D * DEXP, D, DEXP, Wgu + (size_t)e * 1024 * D, 64 * kb, c0, 256 * (c0 >> 7) + 128 * up + (c0 & 127), scr, lane); continue; }
        r -= 2 * I_G;
        { const int nblk = D / 32, kb = r / nblk, nb = r % nblk; transpose_item(p.w_down + (size_t)e * DEXP * D, DEXP, D, Wd + (size_t)e * D * DEXP, 64 * kb, 32 * nb, 32 * nb, scr, lane); }
    }
    bf16* A = (bf16*)(p.ws + WS_R2);
    for (int m = gw; m < MROWS; m += NGW) {
        u32x2* o8 = (u32x2*)(A + (size_t)m * D) + lane;
        if (m >= NTOK + NMETA) {
#pragma unroll
            for (int j = 0; j < 4; ++j) o8[64 * j] = (u32x2){0u, 0u};
            continue; }
        const float* xrow = (m < NTOK) ? p.x + (size_t)m * D : p.meta + (size_t)(m - NTOK) * D;
        const f32x4* xr = (const f32x4*)xrow + lane;
        f32x4 v[4]; float s = 0.f;
#pragma unroll
        for (int j = 0; j < 4; ++j) { v[j] = xr[64 * j]; s += (v[j].x * v[j].x + v[j].y * v[j].y) + (v[j].z * v[j].z + v[j].w * v[j].w); }
        const float rstd = 1.f / sqrtf(wave_sum(s) * (1.f / D) + EPS);
#pragma unroll
        for (int j = 0; j < 4; ++j) { const f32x4 g = ((const f32x4*)p.g1)[lane + 64 * j];
            o8[64 * j] = (u32x2){pk2(v[j].x * rstd * g.x, v[j].y * rstd * g.y), pk2(v[j].z * rstd * g.z, v[j].w * rstd * g.w)}; }
    }
    if (blockIdx.x == 0) {
        float* sm = (float*)(p.ws + WS_SM);
        for (int i = F.tid; i < 12 * 128; i += NWAVES * 64) { const int hd = i >> 7, dist = i & 127; sm[i] = p.rel_bias[t5_bucket(dist) * 12 + hd] * LOG2E; }
        if (F.tid < 64) { const int l = F.tid; const float a = wave_sum(p.lq1[l] * p.lk1[l]), b = wave_sum(p.lq2[l] * p.lk2[l]); if (l == 0) sm[SM_LAM] = expf(a) - expf(b) + 0.2f; }
    }
}

__device__ __forceinline__ void p4_router(Frame& F, const Ptrs& p) {
    const int lane = F.lane, gw = F.vcu * NWAVES + F.wave, NGW = F.G * NWAVES;
    unsigned* ctl = F.ctl;
    for (int tok = gw; tok < NTOK; tok += NGW) {
        const f32x4* hr = (const f32x4*)(p.out + (size_t)tok * D) + lane;
        float t[16]; float s = 0.f;
#pragma unroll
        for (int j = 0; j < 4; ++j) { const f32x4 v = hr[64 * j]; t[4 * j] = v.x; t[4 * j + 1] = v.y; t[4 * j + 2] = v.z; t[4 * j + 3] = v.w; s += (v.x * v.x + v.y * v.y) + (v.z * v.z + v.w * v.w); }
        const float rstd = 1.f / sqrtf(wave_sum(s) * (1.f / D) + EPS);
#pragma unroll
        for (int j = 0; j < 4; ++j) { const f32x4 g = ((const f32x4*)p.g2)[lane + 64 * j]; t[4 * j] *= rstd * g.x; t[4 * j + 1] *= rstd * g.y; t[4 * j + 2] *= rstd * g.z; t[4 * j + 3] *= rstd * g.w; }
        float gl[4];
#pragma unroll
        for (int c = 0; c < 4; ++c) gl[c] = 0.f;
#pragma unroll
        for (int j = 0; j < 4; ++j)
#pragma unroll
            for (int i = 0; i < 4; ++i) { const f32x4 w = *(const f32x4*)(p.w_group + (size_t)(256 * j + 4 * lane + i) * 4); const float tv = t[4 * j + i];
                gl[0] += tv * w.x; gl[1] += tv * w.y; gl[2] += tv * w.z; gl[3] += tv * w.w; }
#pragma unroll
        for (int c = 0; c < 4; ++c) gl[c] = wave_sum(gl[c]) + p.b_group[c];
        int g = 0; float gm = gl[0];
#pragma unroll
        for (int c = 1; c < 4; ++c) if (gl[c] > gm) { gm = gl[c]; g = c; }
        float den = 0.f;
#pragma unroll
        for (int c = 0; c < 4; ++c) den += expf(gl[c] - gm);
        const float g_w = 1.f / den;
        float el[8];
#pragma unroll
        for (int c = 0; c < 8; ++c) el[c] = 0.f;
#pragma unroll
        for (int j = 0; j < 4; ++j)
#pragma unroll
            for (int i = 0; i < 4; ++i) { const float* wp = p.w_router + (size_t)(256 * j + 4 * lane + i) * 32 + g * 8; const f32x4 w0 = *(const f32x4*)wp, w1 = *(const f32x4*)(wp + 4); const float tv = t[4 * j + i];
                el[0] += tv * w0.x; el[1] += tv * w0.y; el[2] += tv * w0.z; el[3] += tv * w0.w; el[4] += tv * w1.x; el[5] += tv * w1.y; el[6] += tv * w1.z; el[7] += tv * w1.w; }
#pragma unroll
        for (int c = 0; c < 8; ++c) el[c] = wave_sum(el[c]) + p.b_router[g * 8 + c];
        int j0 = 0; float l0 = el[0];
#pragma unroll
        for (int c = 1; c < 8; ++c) if (el[c] > l0) { l0 = el[c]; j0 = c; }
        int j1 = -1; float l1 = -3.0e38f;
#pragma unroll
        for (int c = 0; c < 8; ++c) if (c != j0 && el[c] > l1) { l1 = el[c]; j1 = c; }
        const float e1 = expf(l1 - l0), ga = g_w / (1.f + e1), gb = g_w * e1 / (1.f + e1);
        if (lane == 0) {
            const int ea = g * 8 + j0, eb = g * 8 + j1;
            const unsigned pa = atomicAdd(&ctl[CW_CNT + 64 * ea], 1u), pb = atomicAdd(&ctl[CW_CNT + 64 * eb], 1u);
            unsigned* ep = (unsigned*)(p.ws + WS_TOK + TOK_EP); float* gt = (float*)(p.ws + WS_TOK + TOK_GATE);
            ep[2 * tok] = ((unsigned)ea << 20) | pa; ep[2 * tok + 1] = ((unsigned)eb << 20) | pb; gt[2 * tok] = ga; gt[2 * tok + 1] = gb;
        }
    }
}

__device__ __forceinline__ void p5_permute(Frame& F, const Ptrs& p) {
    const LAS int* ps = (const LAS int*)(F.lds + PS_OFF);
    const int lane = F.lane, gw = F.vcu * NWAVES + F.wave, NGW = F.G * NWAVES;
    const unsigned* ep = (const unsigned*)(p.ws + WS_TOK + TOK_EP); const float* gt = (const float*)(p.ws + WS_TOK + TOK_GATE);
    bf16* Xs = (bf16*)(p.ws + WS_R1); float* gs = (float*)(p.ws + WS_TOK + TOK_GSLOT);
    for (int tok = gw; tok < NTOK; tok += NGW) {
        const f32x4* hr = (const f32x4*)(p.out + (size_t)tok * D) + lane;
        f32x4 v[4]; float s = 0.f;
#pragma unroll
        for (int j = 0; j < 4; ++j) { v[j] = hr[64 * j]; s += (v[j].x * v[j].x + v[j].y * v[j].y) + (v[j].z * v[j].z + v[j].w * v[j].w); }
        const float rstd = 1.f / sqrtf(wave_sum(s) * (1.f / D) + EPS);
        u32x2 w[4];
#pragma unroll
        for (int j = 0; j < 4; ++j) { const f32x4 g = ((const f32x4*)p.g2)[lane + 64 * j]; w[j] = (u32x2){pk2(v[j].x * rstd * g.x, v[j].y * rstd * g.y), pk2(v[j].z * rstd * g.z, v[j].w * rstd * g.w)}; }
#pragma unroll
        for (int k = 0; k < 2; ++k) { const unsigned r = ep[2 * tok + k]; const int slot = ps[r >> 20] * 256 + (int)(r & 0xfffffu);
            u32x2* o8 = (u32x2*)(Xs + (size_t)slot * D) + lane;
#pragma unroll
            for (int j = 0; j < 4; ++j) o8[64 * j] = w[j];
            if (lane == 0) gs[slot] = gt[2 * tok + k]; }
    }
}

__device__ __forceinline__ void p8_combine(Frame& F, const Ptrs& p) {
    const LAS int* ps = (const LAS int*)(F.lds + PS_OFF);
    const int lane = F.lane, gw = F.vcu * NWAVES + F.wave, NGW = F.G * NWAVES;
    const unsigned* ep = (const unsigned*)(p.ws + WS_TOK + TOK_EP); const bf16* Y = (const bf16*)(p.ws + WS_R1);
    for (int tok = gw; tok < NTOK; tok += NGW) {
        const unsigned r0 = ep[2 * tok], r1 = ep[2 * tok + 1];
        const int s0 = ps[r0 >> 20] * 256 + (int)(r0 & 0xfffffu), s1 = ps[r1 >> 20] * 256 + (int)(r1 & 0xfffffu);
        f32x4* hr = (f32x4*)(p.out + (size_t)tok * D) + lane;
        const u32x2* y0 = (const u32x2*)(Y + (size_t)s0 * D) + lane; const u32x2* y1 = (const u32x2*)(Y + (size_t)s1 * D) + lane;
#pragma unroll
        for (int j = 0; j < 4; ++j) { f32x4 v = hr[64 * j]; const u32x2 a = y0[64 * j], b = y1[64 * j];
            v.x += bf2f(a.x & 0xffff) + bf2f(b.x & 0xffff); v.y += bf2f(a.x >> 16) + bf2f(b.x >> 16); v.z += bf2f(a.y & 0xffff) + bf2f(b.y & 0xffff); v.w += bf2f(a.y >> 16) + bf2f(b.y >> 16);
            hr[64 * j] = v; }
    }
}


namespace att {
typedef short bf16x8 __attribute__((ext_vector_type(8)));
typedef short s16x4 __attribute__((ext_vector_type(4)));
typedef float f32x16 __attribute__((ext_vector_type(16)));
constexpr int SLOTB = 32768, K1_OFF = 8192, V_OFF = 16384;
constexpr int WSF_OFF = RING_BYTES - 2048;
constexpr int STG_BYTES = 17408;
constexpr int BT_OFF = LDSCTL_OFF + 4096;
constexpr float THR = 8.f;
__device__ __forceinline__ int crow(int r, int hi) { return (r & 3) + 8 * (r >> 2) + 4 * hi; }
__device__ __forceinline__ s16x4 vtr(const LAS unsigned char* p) { typedef short v4i16_t __attribute__((ext_vector_type(4))); return __builtin_bit_cast(s16x4, __builtin_amdgcn_ds_read_tr16_b64_v4i16((LAS v4i16_t*)p)); }
__device__ __forceinline__ unsigned cvtpk(float lo, float hi) { typedef float f2 __attribute__((ext_vector_type(2))); typedef __bf16 b2 __attribute__((ext_vector_type(2))); f2 v = {lo, hi}; b2 b = __builtin_convertvector(v, b2); return __builtin_bit_cast(unsigned, b); }

template <bool DIFF>
__device__ __forceinline__ void attn_unit(Frame& F, const Ptrs& p, int b, int hh, int q0) {
    constexpr int NDH = DIFF ? 4 : 2;
    const bf16* P = (const bf16*)(p.ws + WS_R1); bf16* mix = (bf16*)(p.ws + WS_R2);
    LAS unsigned char* lds = F.lds;
    const int lane = F.lane, r32 = lane & 31, hi = lane >> 5, w = F.wave;
    const int m = DIFF ? (w >> 2) : 0;
    const int r0 = DIFF ? q0 + 32 * (w & 3) : q0 + 32 * (w & 1);
    const int hq = DIFF ? hh : hh * 4 + (w >> 1);
    const int qcol = DIFF ? C_DQ + hh * 128 + m * 64 : C_SQ + hq * 64;
    const int kcol = DIFF ? C_DK + hh * 128 : C_SK + hh * 64;
    const int vcol = DIFF ? C_DV + hh * 128 : C_SV + hh * 64;
    const LAS float* btab = (const LAS float*)(lds + BT_OFF) + (DIFF ? hh : 4 + hq) * 128;
    LAS float* wsf = (LAS float*)(lds + WSF_OFF) + w * 64;
    const int tq = r0 + r32;
    const int tt_first = DIFF ? 0 : ((q0 >> 6) >= 2 ? (q0 >> 6) - 2 : 0), tt_last = DIFF ? (q0 >> 6) + 1 : (q0 >> 6);
    const int NT = 2 + tt_last - tt_first;
    auto dma = [&](int i, int s) {
        const size_t rowbase = (i == 0) ? (size_t)NTOK : (size_t)b * SEQ + 64 * (tt_first + i - 1);
        LAS unsigned char* sl = lds + s * SLOTB;
        const bf16* ks = P + (rowbase + lane) * DIN + kcol + w * 8;
        __builtin_amdgcn_global_load_lds((const unsigned*)ks, (LAS unsigned*)(sl + w * 1024), 16, 0, 0);
        if (DIFF) __builtin_amdgcn_global_load_lds((const unsigned*)(ks + 64), (LAS unsigned*)(sl + K1_OFF + w * 1024), 16, 0, 0);
#pragma unroll
        for (int j = 0; j < (DIFF ? 2 : 1); ++j) { const int id = w + 8 * j, dh = id >> 2, kg = id & 3;
            const bf16* vs = P + (rowbase + 16 * kg + (lane >> 2)) * DIN + vcol + dh * 32 + (lane & 3) * 8;
            __builtin_amdgcn_global_load_lds((const unsigned*)vs, (LAS unsigned*)(sl + V_OFF + id * 1024), 16, 0, 0); }
    };
    dma(0, 0);
    bf16x8 qr[4];
    { const bf16* qp = P + ((size_t)b * SEQ + tq) * DIN + qcol + hi * 8;
#pragma unroll
      for (int d0 = 0; d0 < 4; ++d0) qr[d0] = *(const bf16x8*)(qp + d0 * 16); }
    float mhat = 0.f, l_reg = 0.f;
    f32x16 o[NDH];
#pragma unroll
    for (int dh = 0; dh < NDH; ++dh) o[dh] = f32x16{};
    f32x16 negm = f32x16{};
    const int koff = (DIFF && m) ? K1_OFF : 0;
    for (int i = 0; i < NT; ++i) {
        asm volatile("s_waitcnt vmcnt(0)" ::: "memory");
        __syncthreads();
        if (i + 1 < NT) dma(i + 1, (i + 1) & 1);
        const int tt = tt_first + i - 1;
        const int tok0 = 64 * tt;
        if (i > 0 && tok0 > r0 + 31) continue;
        if (!DIFF && i > 0 && tok0 + 63 < r0 - 127) continue;
        const LAS unsigned char* sl = lds + (i & 1) * SLOTB;
        f32x16 p0 = negm, p1 = negm;
        { const LAS unsigned char* kb = sl + koff + hi * 1024 + r32 * 16;
#pragma unroll
          for (int d0 = 0; d0 < 4; ++d0) { const bf16x8 a0 = *(const LAS bf16x8*)(kb + d0 * 2048), a1 = *(const LAS bf16x8*)(kb + d0 * 2048 + 512);
              p0 = __builtin_amdgcn_mfma_f32_32x32x16_bf16(a0, qr[d0], p0, 0, 0, 0); p1 = __builtin_amdgcn_mfma_f32_32x32x16_bf16(a1, qr[d0], p1, 0, 0, 0); } }
        const bool meta = (i == 0);
        const bool near_ = meta || (DIFF ? (tok0 + 63 >= r0 - 127) : true);
        if (near_) {
            const int delta = meta ? 16 + tq : tq - tok0;
#pragma unroll
            for (int r = 0; r < 16; ++r) { const int kk = crow(r, hi); const int d0_ = delta - kk, d1_ = d0_ - 32;
                const float b0 = btab[min(max(d0_, 0), 127)], b1 = btab[min(max(d1_, 0), 127)];
                bool ok0, ok1;
                if (meta) { ok0 = kk < 16; ok1 = false; }
                else if (DIFF) { ok0 = d0_ >= 0; ok1 = d1_ >= 0; }
                else { ok0 = d0_ >= 0 && d0_ < 128; ok1 = d1_ >= 0 && d1_ < 128; }
                p0[r] = ok0 ? p0[r] + b0 : -INFINITY; p1[r] = ok1 ? p1[r] + b1 : -INFINITY; }
        }
        float rm = fmaxf(p0[0], p1[0]);
#pragma unroll
        for (int r = 1; r < 16; ++r) rm = fmaxf(rm, fmaxf(p0[r], p1[r]));
        { auto rr = __builtin_amdgcn_permlane32_swap(__float_as_uint(rm), __float_as_uint(rm), false, false); rm = fmaxf(__uint_as_float(rr[0]), __uint_as_float(rr[1])); }
        if (__any(rm > THR) || i == 0) {
            const float dl = (i == 0) ? rm : fmaxf(rm, 0.f);
            mhat += dl;
#pragma unroll
            for (int r = 0; r < 16; ++r) { p0[r] -= dl; p1[r] -= dl; negm[r] = -mhat; }
            const float f = __builtin_amdgcn_exp2f(-dl);
            l_reg = (i == 0) ? 0.f : l_reg * f;
            if (i > 0) {
                if (hi == 0) wsf[r32] = f;
                asm volatile("s_waitcnt lgkmcnt(0)" ::: "memory");
#pragma unroll
                for (int g = 0; g < 4; ++g) { const f32x4 fv = *(const LAS f32x4*)(wsf + 8 * g + 4 * hi);
#pragma unroll
                    for (int dh = 0; dh < NDH; ++dh)
#pragma unroll
                        for (int j = 0; j < 4; ++j) o[dh][4 * g + j] *= fv[j]; }
            }
        }
        float sacc = 0.f;
#pragma unroll
        for (int r = 0; r < 16; ++r) { p0[r] = __builtin_amdgcn_exp2f(p0[r]); p1[r] = __builtin_amdgcn_exp2f(p1[r]); sacc += p0[r] + p1[r]; }
        l_reg += sacc;
        u32x4 pw[4];
#pragma unroll
        for (int j = 0; j < 4; ++j) { pw[0][j] = cvtpk(p0[2 * j], p0[2 * j + 1]); pw[1][j] = cvtpk(p0[8 + 2 * j], p0[8 + 2 * j + 1]); pw[2][j] = cvtpk(p1[2 * j], p1[2 * j + 1]); pw[3][j] = cvtpk(p1[8 + 2 * j], p1[8 + 2 * j + 1]); }
        const LAS unsigned char* vb = sl + V_OFF + ((lane >> 4) & 1) * 32 + (lane & 3) * 8 + (4 * hi + ((lane & 15) >> 2)) * 64;
#pragma unroll
        for (int dh = 0; dh < NDH; ++dh)
#pragma unroll
            for (int ks = 0; ks < 4; ++ks) { const s16x4 lo = vtr(vb + dh * 4096 + ks * 1024), hi4 = vtr(vb + dh * 4096 + ks * 1024 + 512);
                const bf16x8 vf = (bf16x8){lo[0], lo[1], lo[2], lo[3], hi4[0], hi4[1], hi4[2], hi4[3]};
                o[dh] = __builtin_amdgcn_mfma_f32_32x32x16_bf16(__builtin_bit_cast(bf16x8, pw[ks]), vf, o[dh], 0, 0, 0); }
    }
    { auto rr = __builtin_amdgcn_permlane32_swap(__float_as_uint(l_reg), __float_as_uint(l_reg), false, false); l_reg = __uint_as_float(rr[0]) + __uint_as_float(rr[1]); }
    if (!DIFF) l_reg += __builtin_amdgcn_exp2f(*((const LAS float*)(lds + BT_OFF) + 12 * 128 + hq) - mhat);
    const float lam = *((const LAS float*)(lds + BT_OFF) + 12 * 128 + 8);
    if (hi == 0) wsf[r32] = ((DIFF && m) ? lam : 1.f) / l_reg;
    asm volatile("s_waitcnt lgkmcnt(0)" ::: "memory");
    float sc[16];
#pragma unroll
    for (int g = 0; g < 4; ++g) { const f32x4 fv = *(const LAS f32x4*)(wsf + 8 * g + 4 * hi); sc[4 * g] = fv[0]; sc[4 * g + 1] = fv[1]; sc[4 * g + 2] = fv[2]; sc[4 * g + 3] = fv[3]; }
    __syncthreads();
    if (DIFF) {
        LAS float* ex = (LAS float*)(lds + (w & 3) * STG_BYTES);
        if (m) {
#pragma unroll
            for (int dh = 0; dh < NDH; ++dh)
#pragma unroll
                for (int r = 0; r < 16; ++r) ex[(dh * 16 + r) * 64 + lane] = o[dh][r] * sc[r];
        }
        __syncthreads();
        if (!m) {
#pragma unroll
            for (int dh = 0; dh < NDH; ++dh)
#pragma unroll
                for (int r = 0; r < 16; ++r) o[dh][r] = o[dh][r] * sc[r] - ex[(dh * 16 + r) * 64 + lane];
            asm volatile("s_waitcnt lgkmcnt(0)" ::: "memory");
#pragma unroll
            for (int dh = 0; dh < NDH; ++dh)
#pragma unroll
                for (int r = 0; r < 16; ++r) ex[crow(r, hi) * 132 + dh * 32 + r32] = o[dh][r];
            asm volatile("s_waitcnt lgkmcnt(0)" ::: "memory");
            const int row = lane >> 1, half = lane & 1;
            f32x4 v[16]; float ss = 0.f;
#pragma unroll
            for (int j = 0; j < 16; ++j) { v[j] = *(const LAS f32x4*)(ex + row * 132 + half * 64 + 4 * j); ss += (v[j][0] * v[j][0] + v[j][1] * v[j][1]) + (v[j][2] * v[j][2] + v[j][3] * v[j][3]); }
            ss += __shfl_xor(ss, 1);
            const float rstd = 0.8f / sqrtf(ss * (1.f / 128.f) + EPS);
            bf16* op = mix + ((size_t)b * SEQ + r0 + row) * D + hh * 128 + half * 64;
#pragma unroll
            for (int j = 0; j < 16; j += 2) { const f32x4 g0 = *(const f32x4*)(p.subg + half * 64 + 4 * j), g1 = *(const f32x4*)(p.subg + half * 64 + 4 * j + 4);
                *(u32x4*)(op + 4 * j) = (u32x4){cvtpk(v[j][0] * rstd * g0[0], v[j][1] * rstd * g0[1]), cvtpk(v[j][2] * rstd * g0[2], v[j][3] * rstd * g0[3]), cvtpk(v[j + 1][0] * rstd * g1[0], v[j + 1][1] * rstd * g1[1]), cvtpk(v[j + 1][2] * rstd * g1[2], v[j + 1][3] * rstd * g1[3])}; }
        }
    } else {
        LAS float* ex = (LAS float*)(lds + w * 8704);
#pragma unroll
        for (int dh = 0; dh < NDH; ++dh)
#pragma unroll
            for (int r = 0; r < 16; ++r) ex[crow(r, hi) * 68 + dh * 32 + r32] = o[dh][r] * sc[r];
        asm volatile("s_waitcnt lgkmcnt(0)" ::: "memory");
        const int row = lane >> 1, half = lane & 1;
        bf16* op = mix + ((size_t)b * SEQ + r0 + row) * D + 512 + hq * 64 + half * 32;
#pragma unroll
        for (int j = 0; j < 8; j += 2) { const f32x4 a = *(const LAS f32x4*)(ex + row * 68 + half * 32 + 4 * j), c = *(const LAS f32x4*)(ex + row * 68 + half * 32 + 4 * j + 4);
            *(u32x4*)(op + 4 * j) = (u32x4){cvtpk(a[0], a[1]), cvtpk(a[2], a[3]), cvtpk(c[0], c[1]), cvtpk(c[2], c[3])}; }
    }
    __syncthreads();
}

__device__ __forceinline__ void attn_phase(Frame& F, const Ptrs& p) {
    { const float* sm = (const float*)(p.ws + WS_SM); LAS float* bt = (LAS float*)(F.lds + BT_OFF);
      for (int i = F.tid; i < 12 * 128; i += NWAVES * 64) bt[i] = sm[i] - sm[(i & ~127) + 127];
      if (F.tid < 8) bt[12 * 128 + F.tid] = p.sinks[F.tid] * LOG2E - sm[(4 + F.tid) * 128 + 127];
      if (F.tid == 8) bt[12 * 128 + 8] = sm[SM_LAM]; }
    __syncthreads();
    for (int v = F.vcu; v < 256; v += F.G) { const int bh = v >> 4, s = v & 15;
        attn_unit<true>(F, p, bh >> 2, bh & 3, 128 * (31 - s)); attn_unit<true>(F, p, bh >> 2, bh & 3, 128 * s); }
    for (int u = F.vcu; u < 512; u += F.G) { const int bk = u >> 6, qb = u & 63; attn_unit<false>(F, p, bk >> 1, bk & 1, 64 * qb); }
}
}

struct Args { Ptrs p; int ph_lo, ph_hi, li, pad; };
__global__ void __launch_bounds__(NWAVES * 64, 2) mk(Args args) {
    extern __shared__ __attribute__((aligned(16))) unsigned char lds[];
    Frame F;
    F.lds = (LAS unsigned char*)lds; F.MISC = (volatile LAS unsigned*)(F.lds + MISC_OFF);
    F.tid = threadIdx.x; F.lane = F.tid & 63; F.wave = __builtin_amdgcn_readfirstlane(F.tid >> 6);
    F.G = gridDim.x; { const int bx = blockIdx.x; F.vcu = (F.G % 8 == 0) ? (bx % 8) * (F.G / 8) + bx / 8 : bx; }
    const Ptrs& p = args.p;
    F.ctl = (unsigned*)(p.ws + WS_CTL);
    for (int u = F.tid; u < (LDS_BYTES - LDSCTL_OFF) / 4; u += NWAVES * 64) ((LAS unsigned*)(F.lds + LDSCTL_OFF))[u] = 0u;
    __syncthreads();
    XcdBarrier bar = xcd_barrier_post(F.ctl + CW_BAR + args.li * XCD_BAR_WORDS, F.MISC + 8);
    const int lo = args.ph_lo, hi = args.ph_hi;
#define IN(k) (lo <= (k) && (k) < hi)
#define SEAM(k) do { if (IN(k) && IN((k) + 1)) xcd_barrier(bar); } while (0)

    if (IN(0)) { p0_prologue(F, p); SEAM(0); }
    if (IN(1)) {
        pg8::Gemm g{(const bf16*)(p.ws + WS_R2), (const bf16*)(p.ws + WS_WIN), MROWS, DIN, D}; pg8::StaticOrder S; S.init(MROWS, DIN, F.G, (int)blockIdx.x);
        pg8::EpiProj E{(bf16*)(p.ws + WS_R1), p.dqg, p.dkg, p.sqg, p.skg};
        pg8::gemm_phase<pg8::EpiProj, pg8::StaticOrder, true, true>(F.lds, g, S, E);
        SEAM(1);
    }
    if (IN(2)) { att::attn_phase(F, p); SEAM(2); }
    if (IN(3)) {
        pg8::Gemm g{(const bf16*)(p.ws + WS_R2), (const bf16*)(p.ws + WS_WOUT), NTOK, D, D}; pg8::StaticOrder S; S.init(NTOK, D, F.G, (int)blockIdx.x);
        pg8::EpiOut E{p.x, p.out};
        pg8::gemm_phase<pg8::EpiOut, pg8::StaticOrder, true, true>(F.lds, g, S, E);
        SEAM(3);
    }
    if (IN(4)) { p4_router(F, p); SEAM(4); }
    if (IN(5)) { moe_tables(F); p5_permute(F, p); SEAM(5); }
    if (IN(6)) {
        moe_tables(F);
        const int ntile = *(const LAS int*)(F.lds + PS_OFF + 32 * 4);
        pg8::Gemm g{(const bf16*)(p.ws + WS_R1), (const bf16*)(p.ws + WS_WGU), ntile * 256, 1024, D};
        pg8::MoeOrder S; S.so.init(ntile * 256, 1024, F.G, (int)blockIdx.x); S.tile_e = (const LAS int*)(F.lds + TILEE_OFF);
        pg8::EpiGU E{(bf16*)(p.ws + WS_R2)};
        pg8::gemm_phase<pg8::EpiGU, pg8::MoeOrder, true, true>(F.lds, g, S, E);
        SEAM(6);
    }
    if (IN(7)) {
        moe_tables(F);
        const int ntile = *(const LAS int*)(F.lds + PS_OFF + 32 * 4);
        pg8::Gemm g{(const bf16*)(p.ws + WS_R2), (const bf16*)(p.ws + WS_WD), ntile * 256, 1024, DEXP};
        pg8::MoeOrder S; S.so.init(ntile * 256, 1024, F.G, (int)blockIdx.x); S.tile_e = (const LAS int*)(F.lds + TILEE_OFF);
        pg8::EpiDown E{(bf16*)(p.ws + WS_R1), (const float*)(p.ws + WS_TOK + TOK_GSLOT)};
        pg8::gemm_phase<pg8::EpiDown, pg8::MoeOrder, true, true>(F.lds, g, S, E);
        SEAM(7);
    }
    if (IN(8)) { moe_tables(F); p8_combine(F, p); }
#undef IN
#undef SEAM
}

extern "C" void kernel_launch(void* const* d_in, const int* in_sizes, int n_in, void* d_out, int out_size, void* d_ws, size_t ws_size, hipStream_t stream) {
    static int grid = 0;
    if (grid == 0) {
        if (n_in != 24 || in_sizes[0] != NTOK * D || out_size != NTOK * D || ws_size < WS_END) { fprintf(stderr, "kernel_launch: unexpected shapes (n_in %d, in0 %d, out %d, ws %zu)\n", n_in, n_in > 0 ? in_sizes[0] : -1, out_size, ws_size); grid = -1; return; }
        int dev = 0, cus = 0, per_cu = 0;
        if (hipGetDevice(&dev) != hipSuccess || hipDeviceGetAttribute(&cus, hipDeviceAttributeMultiprocessorCount, dev) != hipSuccess) { grid = -1; return; }
        if (hipFuncSetAttribute((const void*)mk, hipFuncAttributeMaxDynamicSharedMemorySize, LDS_BYTES) != hipSuccess) { fprintf(stderr, "kernel_launch: hipFuncSetAttribute failed\n"); grid = -1; return; }
        if (hipOccupancyMaxActiveBlocksPerMultiprocessor(&per_cu, (const void*)mk, NWAVES * 64, LDS_BYTES) != hipSuccess || per_cu < 1) fprintf(stderr, "kernel_launch: occupancy query reports %d\n", per_cu);
        (void)hipGetLastError();
        grid = cus;
    }
    if (grid < 0) return;
    Args a{};
    const float** f = (const float**)&a.p;
    for (int i = 0; i < 24; ++i) f[i] = (const float*)d_in[i];
    a.p.out = (float*)d_out; a.p.ws = (unsigned char*)d_ws;
    (void)hipMemsetAsync((char*)d_ws + WS_CTL, 0, CTL_ZERO_BYTES, stream);
    a.ph_lo = 0; a.ph_hi = NPHASE; a.li = 0;
    hipLaunchKernelGGL(mk, dim3(grid), dim3(NWAVES * 64), LDS_BYTES, stream, a);
}
```

```cpp
#include <hip/hip_runtime.h>
#include <cstdio>
#include <cstdint>

typedef unsigned short bf16;
typedef unsigned u32x4 __attribute__((ext_vector_type(4)));
typedef unsigned u32x2 __attribute__((ext_vector_type(2)));
typedef float f32x4 __attribute__((ext_vector_type(4)));

constexpr int NB = 4, SEQ = 4096, D = 1024, NTOK = NB * SEQ, NMETA = 16;
constexpr int MROWS = NTOK + 256;
constexpr int DIN = 2304;
constexpr int C_DQ = 0, C_DK = 512, C_DV = 1024, C_SQ = 1536, C_SK = 2048, C_SV = 2176;
constexpr int NEXP = 32, DEXP = 512;
constexpr int LISTCAP = 16384;
constexpr int MAXSLOT = 40960;
constexpr float EPS = 1e-6f;
constexpr float LOG2E = 1.4426950408889634f;
constexpr float C2 = 0.125f * LOG2E;

constexpr size_t MiB = 1u << 20;
constexpr size_t WS_CTL = 0, CTL_ZERO_BYTES = 1 * MiB;
constexpr size_t WS_SM = 1 * MiB;
constexpr size_t WS_TOK = 2 * MiB;
constexpr size_t WS_WIN = 4 * MiB, WS_WOUT = 9 * MiB, WS_WGU = 12 * MiB, WS_WD = 76 * MiB;
constexpr size_t WS_R1 = 108 * MiB;
constexpr size_t WS_R2 = 188 * MiB;
constexpr size_t WS_LIST = 228 * MiB;
constexpr size_t WS_END = 232 * MiB;
constexpr int CW_BAR = 4096;
constexpr int CW_CNT = 16384;
constexpr int SM_BIASD = 0, SM_BIASS = 512, SM_LAM = 1536;
constexpr size_t TOK_EP = 0, TOK_GATE = 131072, TOK_GSLOT = 262144, TOK_TILEE = 262144 + 163840, TOK_NT = TOK_TILEE + 1024;

__device__ __forceinline__ float bf2f(bf16 v) { return __builtin_bit_cast(float, (unsigned)v << 16); }
__device__ __forceinline__ unsigned f2bf(float f) { unsigned u = __builtin_bit_cast(unsigned, f); return (u + 0x7fffu + ((u >> 16) & 1u)) >> 16; }
__device__ __forceinline__ unsigned pk2(float lo, float hi) { return f2bf(lo) | (f2bf(hi) << 16); }
__device__ __forceinline__ float wave_sum(float v) {
#pragma unroll
    for (int o = 1; o < 64; o <<= 1) v += __shfl_xor(v, o);
    return v;
}
__device__ __forceinline__ int t5_bucket(int n) {
    if (n < 16) return n;
    const int st[16] = {16, 19, 21, 24, 27, 31, 35, 40, 46, 52, 59, 67, 77, 87, 99, 113};
    int b = 15;
#pragma unroll
    for (int i = 0; i < 16; ++i) b += (n >= st[i]) ? 1 : 0;
    return b;
}
__host__ __device__ __forceinline__ int win_row_of_col(int c) { const int T = c >> 8, r = c & 255, wc = r >> 6, bj = (r >> 5) & 1, i = r & 31; return T * 256 + bj * 128 + wc * 32 + i; }

struct Ptrs {
    const float *x, *meta, *rel_bias, *g1, *w_in, *dqg, *dkg, *lq1, *lk1, *lq2, *lk2, *subg, *sqg, *skg, *sinks, *w_out, *g2, *w_group, *b_group, *w_router, *b_router, *w_gate, *w_up, *w_down;
    float* out; unsigned char* ws;
};

#define LAS __attribute__((address_space(3)))
__device__ __forceinline__ void transpose_item(const float* W, int K, int N, bf16* WT, int k0, int n0, int drow0, float* scr, int lane) {
#pragma unroll 8
    for (int i = 0; i < 32; ++i) { const int kk = 2 * i + (lane >> 5); scr[kk * 33 + (lane & 31)] = W[(size_t)(k0 + kk) * N + n0 + (lane & 31)]; }
    asm volatile("s_waitcnt lgkmcnt(0)" ::: "memory");
    const int c = lane & 7;
#pragma unroll
    for (int j = 0; j < 4; ++j) { const int n = (lane >> 3) + 8 * j; const float* s = scr + (8 * c) * 33 + n;
        u32x4 o; o.x = pk2(s[0 * 33], s[1 * 33]); o.y = pk2(s[2 * 33], s[3 * 33]); o.z = pk2(s[4 * 33], s[5 * 33]); o.w = pk2(s[6 * 33], s[7 * 33]);
        *(u32x4*)(WT + (size_t)(drow0 + n) * K + k0 + 8 * c) = o; }
    asm volatile("s_waitcnt lgkmcnt(0)" ::: "memory");
}


namespace pg8 {
#define PG8_LAS __attribute__((address_space(3)))
typedef unsigned short bf16_t;
typedef short bf16x8 __attribute__((ext_vector_type(8)));
typedef float f32x4 __attribute__((ext_vector_type(4)));
typedef unsigned u32x4 __attribute__((ext_vector_type(4)));
constexpr int BM = 256, BK = 64, HALF = 128, HTB = HALF * BK * 2  , STAGE_BYTES = 8 * HTB, NXCD = 8, WGM = 8;

__host__ __device__ __forceinline__ int lds_byte(int r, int c) { const int st = (r >> 4) * 2 + (c >> 5), rr = r & 15, cc = c & 31, ob = rr * 64 + cc * 2; return st * 1024 + (ob ^ (((ob >> 9) & 1) << 5)); }
__host__ __device__ __forceinline__ void stage_rc(int b, int& R, int& C) { const int st = b / 1024, sb = b % 1024, swz = sb ^ (((sb >> 9) & 1) << 5); R = (st >> 1) * 16 + swz / 64; C = (st & 1) * 32 + (swz % 64) / 2; }
__host__ __device__ __forceinline__ int perm32(int rho) { const int n = rho >> 4, i = rho & 15; return 8 * (i >> 2) + 4 * n + (i & 3); }

struct Unit { int pm, pn; };
struct Gemm { const bf16_t* A; const bf16_t* Bt; int M, N, K; };

struct StaticOrder {
    int nM, nN, nwg, G, c;
    __host__ __device__ void init(int M, int N, int G_, int c_) { nM = M / BM; nN = N / BM; nwg = nM * nN; G = G_; c = c_; }
    __host__ __device__ bool next(int i, Unit& u) const {
        const long L = (long)i * G + c; if (L >= nwg) return false;
        int wgid = (int)L; { const int q = nwg / NXCD, r = nwg % NXCD, xcd = wgid % NXCD, off = wgid / NXCD; wgid = (xcd < r ? xcd * (q + 1) : r * (q + 1) + (xcd - r) * q) + off; }
        const int nig = WGM * nN, gid = wgid / nig, fm = gid * WGM, gsz = (nM - fm) < WGM ? (nM - fm) : WGM;
        u.pm = fm + ((wgid % nig) % gsz); u.pn = (wgid % nig) / gsz; return true;
    }
    __device__ __forceinline__ void a_ready(const Unit&) const {}
    __device__ __forceinline__ void done(const Unit&) const {}
};


__device__ __forceinline__ unsigned cvt_pk_bf16(float lo, float hi) { unsigned r; asm volatile("v_cvt_pk_bf16_f32 %0, %1, %2" : "=v"(r) : "v"(lo), "v"(hi)); return r; }
__device__ __forceinline__ u32x4 pack8(const f32x4 a, const f32x4 b) { u32x4 w; w.x = cvt_pk_bf16(a[0], a[1]); w.y = cvt_pk_bf16(a[2], a[3]); w.z = cvt_pk_bf16(b[0], b[1]); w.w = cvt_pk_bf16(b[2], b[3]); return w; }

struct EpiProj {
    static constexpr bool PERM = true, AFTER_DRAIN = false;
    bf16_t* P; const float *dqg, *dkg, *sqg, *skg;
    __device__ __forceinline__ void operator()(const f32x4 (&acc)[2][2][4][2], const Unit& u, int wr, int wc, int fr, int fq) const {
        const int chunk = u.pn * 4 + wc;
        bool kind = false; const float* gain = dqg; float sc = 1.f;
        if (chunk < 8) { kind = true; gain = dqg; sc = C2; } else if (chunk < 16) { kind = true; gain = dkg; } else if (chunk < 24) { kind = false; }
        else if (chunk < 32) { kind = true; gain = sqg; sc = C2; } else if (chunk < 34) { kind = true; gain = skg; }
        f32x4 gv[2][2];
#pragma unroll
        for (int bj = 0; bj < 2; ++bj)
#pragma unroll
            for (int n = 0; n < 2; ++n) gv[bj][n] = kind ? *(const f32x4*)(gain + 32 * bj + 8 * fq + 4 * n) * sc : (f32x4){1.f, 1.f, 1.f, 1.f};
        const int row0 = u.pm * BM + wr * 64 + fr, col0 = u.pn * BM + 64 * wc + 8 * fq;
#pragma unroll
        for (int ai = 0; ai < 2; ++ai)
#pragma unroll
            for (int m = 0; m < 4; ++m) {
                float ss = 0.f;
#pragma unroll
                for (int bj = 0; bj < 2; ++bj)
#pragma unroll
                    for (int n = 0; n < 2; ++n) { const f32x4 v = acc[ai][bj][m][n]; ss += (v[0] * v[0] + v[1] * v[1]) + (v[2] * v[2] + v[3] * v[3]); }
                ss += __shfl_xor(ss, 16); ss += __shfl_xor(ss, 32);
                const float rstd = kind ? 1.f / sqrtf(ss * (1.f / 64.f) + EPS) : 1.f;
                bf16_t* rowp = P + (size_t)(row0 + ai * HALF + m * 16) * DIN + col0;
#pragma unroll
                for (int bj = 0; bj < 2; ++bj) *(u32x4*)(rowp + 32 * bj) = pack8(acc[ai][bj][m][0] * gv[bj][0] * rstd, acc[ai][bj][m][1] * gv[bj][1] * rstd);
            }
    }
};
struct EpiOut {
    static constexpr bool PERM = true, AFTER_DRAIN = false;
    const float* x; float* out;
    __device__ __forceinline__ void operator()(const f32x4 (&acc)[2][2][4][2], const Unit& u, int wr, int wc, int fr, int fq) const {
        const int row0 = u.pm * BM + wr * 64 + fr, col0 = u.pn * BM + wc * 32 + 8 * fq;
#pragma unroll
        for (int ai = 0; ai < 2; ++ai)
#pragma unroll
            for (int m = 0; m < 4; ++m)
#pragma unroll
                for (int bj = 0; bj < 2; ++bj) { const size_t o = (size_t)(row0 + ai * HALF + m * 16) * D + col0 + bj * HALF;
                    const f32x4 x0 = *(const f32x4*)(x + o), x1 = *(const f32x4*)(x + o + 4);
                    *(f32x4*)(out + o) = x0 + acc[ai][bj][m][0]; *(f32x4*)(out + o + 4) = x1 + acc[ai][bj][m][1]; }
    }
};
struct EpiGU {
    static constexpr bool PERM = true, AFTER_DRAIN = false;
    bf16_t* H;
    __device__ __forceinline__ void operator()(const f32x4 (&acc)[2][2][4][2], const Unit& u, int wr, int wc, int fr, int fq) const {
        const int pnl = u.pn & 3, row0 = u.pm * BM + wr * 64 + fr, col0 = pnl * 128 + wc * 32 + 8 * fq;
#pragma unroll
        for (int ai = 0; ai < 2; ++ai)
#pragma unroll
            for (int m = 0; m < 4; ++m) { f32x4 v[2];
#pragma unroll
                for (int n = 0; n < 2; ++n)
#pragma unroll
                    for (int i = 0; i < 4; ++i) { const float g = acc[ai][0][m][n][i]; v[n][i] = g * __builtin_amdgcn_rcpf(1.f + __builtin_amdgcn_exp2f(-LOG2E * g)) * acc[ai][1][m][n][i]; }
                *(u32x4*)(H + (size_t)(row0 + ai * HALF + m * 16) * DEXP + col0) = pack8(v[0], v[1]); }
    }
};
struct EpiDown {
    static constexpr bool PERM = true, AFTER_DRAIN = false;
    bf16_t* Y; const float* lgate; const PG8_LAS int* ps;
    __device__ __forceinline__ void operator()(const f32x4 (&acc)[2][2][4][2], const Unit& u, int wr, int wc, int fr, int fq) const {
        const int pnl = u.pn & 3, e = u.pn >> 2, row0 = u.pm * BM + wr * 64 + fr, col0 = pnl * BM + wc * 32 + 8 * fq;
        const float* gl = lgate + (size_t)e * LISTCAP + (u.pm - ps[e]) * BM + wr * 64 + fr;
#pragma unroll
        for (int ai = 0; ai < 2; ++ai)
#pragma unroll
            for (int m = 0; m < 4; ++m) { const int r = row0 + ai * HALF + m * 16; const float g = gl[ai * HALF + m * 16];
#pragma unroll
                for (int bj = 0; bj < 2; ++bj) *(u32x4*)(Y + (size_t)r * D + col0 + bj * HALF) = pack8(acc[ai][bj][m][0] * g, acc[ai][bj][m][1] * g); }
    }
};
struct MoeOrder {
    StaticOrder so; const PG8_LAS int* tile_e; const PG8_LAS int* ps; const unsigned* ltok; const unsigned* cnt;
    __device__ __forceinline__ bool next(int i, Unit& u) const { if (!so.next(i, u)) return false; u.pn += 4 * tile_e[u.pm]; return true; }
    __device__ __forceinline__ unsigned row_off(const Unit& u, int row) const { const int e = u.pn >> 2, idx = (u.pm - ps[e]) * BM + row;
        const unsigned n = cnt[64 * e]; const unsigned tok = ((unsigned)idx < n) ? ltok[(size_t)e * LISTCAP + idx] : 0u; return tok * (unsigned)(D * 2); }
    __device__ __forceinline__ void a_ready(const Unit&) const {}
    __device__ __forceinline__ void done(const Unit&) const {}
};

template <class Epi, class Sched, bool ALIGN_EPI = false, bool SP2 = false, bool GATHER = false>
__device__ __forceinline__ void gemm_phase(PG8_LAS unsigned char* lds, const Gemm g, const Sched& S, const Epi& E) {
    const int tid = threadIdx.x, wid = __builtin_amdgcn_readfirstlane(tid >> 6), lane = tid & 63, wr = wid >> 2, wc = wid & 3, fr = lane & 15, fq = lane >> 4;
    const int K = g.K, nt = K / BK;
    unsigned voffA[2], voffB[2];
#pragma unroll
    for (int i = 0; i < 2; ++i) { int R, C; stage_rc(tid * 16 + i * 8192, R, C); const int Rb = Epi::PERM ? ((R & ~31) + perm32(R & 31)) : R;
        voffA[i] = (unsigned)(R * K + C) * 2u; voffB[i] = (unsigned)(Rb * K + C) * 2u; }
    static_assert(!GATHER || SP2, "GATHER is written for the SP2 loop");
    unsigned gC[2][2], gN[2][2]; int gR[2], gCol[2];
#pragma unroll
    for (int i = 0; i < 2; ++i) { int R, C; stage_rc(tid * 16 + i * 8192, R, C); gR[i] = R; gCol[i] = C * 2; }
#define PG8_GLOOK(dst, u) do { _Pragma("unroll") for (int _h = 0; _h < 2; ++_h) _Pragma("unroll") for (int _i = 0; _i < 2; ++_i) dst[_h][_i] = S.row_off(u, _h * HALF + gR[_i]) + (unsigned)gCol[_i]; } while (0)
#define PG8_STAGE_A(bufoff, gbase, h, nx) do { if constexpr (GATHER) { _Pragma("unroll") for (int _i = 0; _i < 2; ++_i) \
        __builtin_amdgcn_global_load_lds((const unsigned*)((const char*)(gbase) + ((nx) ? gN[h][_i] : gC[h][_i])), (PG8_LAS unsigned*)(lds + (bufoff) + ldsw + _i * 8192), 16, 0, 0); } \
    else { PG8_STAGE(bufoff, (gbase) + (h) * hstep, voffA); } } while (0)
    const size_t kstep = (size_t)(BK * 2);
    const size_t hstep = (size_t)HALF * K * 2;
    const size_t tstep = 2 * hstep;
    const unsigned ldsw = (unsigned)wid * 1024u;
    const int aoff = lds_byte(wr * 64 + fr, fq * 8), boff = lds_byte(wc * 32 + fr, fq * 8);
#define PG8_SA(b, h) (((b) * 2 + (h)) * HTB)
#define PG8_SB(b, h) ((4 + (b) * 2 + (h)) * HTB)
#define PG8_STAGE(bufoff, gbase, voff) do { _Pragma("unroll") for (int _i = 0; _i < 2; ++_i) \
        __builtin_amdgcn_global_load_lds((const unsigned*)((const char*)(gbase) + (voff)[_i]), (PG8_LAS unsigned*)(lds + (bufoff) + ldsw + _i * 8192), 16, 0, 0); } while (0)
#define PG8_LDA(dst, b, h) do { _Pragma("unroll") for (int m = 0; m < 4; ++m) _Pragma("unroll") for (int k = 0; k < 2; ++k) dst[m][k] = *(const PG8_LAS bf16x8*)(lds + PG8_SA(b, h) + aoff + m * 2048 + k * 1024); } while (0)
#define PG8_LDB(dst, b, h) do { _Pragma("unroll") for (int n = 0; n < 2; ++n) _Pragma("unroll") for (int k = 0; k < 2; ++k) dst[n][k] = *(const PG8_LAS bf16x8*)(lds + PG8_SB(b, h) + boff + n * 2048 + k * 1024); } while (0)
#define PG8_MMA(ai, bj, At, Bt) do { __builtin_amdgcn_s_setprio(1); _Pragma("unroll") for (int m = 0; m < 4; ++m) _Pragma("unroll") for (int n = 0; n < 2; ++n) _Pragma("unroll") for (int k = 0; k < 2; ++k) \
        acc[ai][bj][m][n] = __builtin_amdgcn_mfma_f32_16x16x32_bf16(Bt[n][k], At[m][k], acc[ai][bj][m][n], 0, 0, 0); __builtin_amdgcn_s_setprio(0); } while (0)
#define PG8_WAIT_V(n) asm volatile("s_waitcnt vmcnt(" #n ")" ::: "memory")
#define PG8_WAIT_L(n) asm volatile("s_waitcnt lgkmcnt(" #n ")" ::: "memory")
#define PG8_BAR __builtin_amdgcn_s_barrier()
#define PG8_SCHED __builtin_amdgcn_sched_barrier(0)
    Unit cur, nxt; int ui = 0;
    if (!S.next(0, cur)) return;
    f32x4 acc[2][2][4][2];
#pragma unroll
    for (int a = 0; a < 2; ++a)
#pragma unroll
        for (int b = 0; b < 2; ++b)
#pragma unroll
            for (int m = 0; m < 4; ++m)
#pragma unroll
                for (int n = 0; n < 2; ++n) acc[a][b][m][n] = (f32x4){0.f, 0.f, 0.f, 0.f};
    bf16x8 At[4][2], B0[2][2], B1[2][2];
    const char* cA = GATHER ? (const char*)g.A : (const char*)g.A + (size_t)cur.pm * tstep; const char* cB = (const char*)g.Bt + (size_t)cur.pn * tstep;
    if constexpr (GATHER) { PG8_GLOOK(gC, cur); }
    S.a_ready(cur);
    if constexpr (SP2) {
        PG8_STAGE(PG8_SB(0, 0), cB, voffB); PG8_STAGE(PG8_SB(0, 1), cB + hstep, voffB); PG8_STAGE_A(PG8_SA(0, 0), cA, 0, false); PG8_STAGE_A(PG8_SA(0, 1), cA, 1, false);
        if (wr == 1) PG8_BAR;
        PG8_WAIT_V(2); PG8_BAR;
        PG8_STAGE(PG8_SB(1, 0), cB + kstep, voffB); PG8_STAGE_A(PG8_SA(1, 0), cA + kstep, 0, false); PG8_STAGE(PG8_SB(1, 1), cB + hstep + kstep, voffB);
        PG8_WAIT_V(6); PG8_BAR;
    } else {
        PG8_STAGE(PG8_SB(0, 0), cB, voffB); PG8_STAGE(PG8_SA(0, 0), cA, voffA); PG8_STAGE(PG8_SB(0, 1), cB + hstep, voffB); PG8_STAGE(PG8_SA(0, 1), cA + hstep, voffA);
        if (wr == 1) PG8_BAR;
        PG8_WAIT_V(4); PG8_BAR;
        PG8_STAGE(PG8_SB(1, 0), cB + kstep, voffB); PG8_STAGE(PG8_SA(1, 0), cA + kstep, voffA); PG8_STAGE(PG8_SB(1, 1), cB + hstep + kstep, voffB);
        PG8_WAIT_V(6); PG8_BAR;
    }
    for (;;) {
        const bool has_next = S.next(ui + 1, nxt);
        const char* nA = (has_next && !GATHER) ? (const char*)g.A + (size_t)nxt.pm * tstep : cA; const char* nB = has_next ? (const char*)g.Bt + (size_t)nxt.pn * tstep : cB;
        if constexpr (GATHER) { if (has_next) { PG8_GLOOK(gN, nxt); } else {
#pragma unroll
            for (int _h = 0; _h < 2; ++_h)
#pragma unroll
                for (int _i = 0; _i < 2; ++_i) gN[_h][_i] = gC[_h][_i]; } }
        for (int t = 0; t < nt; t += 2) {
            const bool last = (t == nt - 2);
            const char* a1 = cA + (size_t)(t + 1) * kstep;
            const char* a2 = last ? nA : cA + (size_t)(t + 2) * kstep; const char* b2 = last ? nB : cB + (size_t)(t + 2) * kstep;
            const char* a3 = a2 + kstep; const char* b3 = b2 + kstep;
            if (last && has_next) S.a_ready(nxt);
            if constexpr (SP2) {
            PG8_LDB(B0, 0, 0); PG8_LDB(B1, 0, 1); PG8_SCHED; PG8_LDA(At, 0, 0); PG8_STAGE_A(PG8_SA(1, 1), a1, 1, false);
            PG8_WAIT_V(8); PG8_WAIT_L(0); PG8_BAR; PG8_MMA(0, 0, At, B0); PG8_MMA(0, 1, At, B1); PG8_BAR; PG8_SCHED;
            PG8_LDA(At, 0, 1); PG8_STAGE(PG8_SB(0, 0), b2, voffB); PG8_STAGE(PG8_SB(0, 1), b2 + hstep, voffB); PG8_STAGE_A(PG8_SA(0, 0), a2, 0, last);
            PG8_WAIT_V(8); PG8_WAIT_L(0); PG8_BAR; PG8_MMA(1, 0, At, B0); PG8_MMA(1, 1, At, B1); PG8_BAR; PG8_SCHED;
            PG8_LDB(B0, 1, 0); PG8_LDB(B1, 1, 1); PG8_SCHED; PG8_LDA(At, 1, 0); PG8_STAGE_A(PG8_SA(0, 1), a2, 1, last);
            PG8_WAIT_V(8); PG8_WAIT_L(0); PG8_BAR; PG8_MMA(0, 0, At, B0); PG8_MMA(0, 1, At, B1); PG8_BAR; PG8_SCHED;
            PG8_LDA(At, 1, 1); PG8_STAGE(PG8_SB(1, 0), b3, voffB); PG8_STAGE(PG8_SB(1, 1), b3 + hstep, voffB); PG8_STAGE_A(PG8_SA(1, 0), a3, 0, last);
            PG8_WAIT_V(8); PG8_WAIT_L(0); PG8_BAR; PG8_MMA(1, 0, At, B0); PG8_MMA(1, 1, At, B1); PG8_BAR; PG8_SCHED;
            } else {
            PG8_LDB(B0, 0, 0); PG8_SCHED; PG8_LDA(At, 0, 0); PG8_STAGE(PG8_SA(1, 1), a1 + hstep, voffA);
            PG8_WAIT_L(8); PG8_BAR; PG8_WAIT_L(0); PG8_MMA(0, 0, At, B0); PG8_BAR; PG8_SCHED;
            PG8_LDB(B1, 0, 1); PG8_STAGE(PG8_SB(0, 0), b2, voffB);
            PG8_BAR; PG8_WAIT_L(0); PG8_MMA(0, 1, At, B1); PG8_BAR;
            PG8_LDA(At, 0, 1); PG8_STAGE(PG8_SA(0, 0), a2, voffA);
            PG8_BAR; PG8_WAIT_L(0); PG8_MMA(1, 0, At, B0); PG8_BAR; PG8_SCHED;
            PG8_STAGE(PG8_SB(0, 1), b2 + hstep, voffB);
            PG8_WAIT_V(6); PG8_BAR; PG8_MMA(1, 1, At, B1); PG8_BAR;
            PG8_LDB(B0, 1, 0); PG8_SCHED; PG8_LDA(At, 1, 0); PG8_STAGE(PG8_SA(0, 1), a2 + hstep, voffA);
            PG8_WAIT_L(8); PG8_BAR; PG8_WAIT_L(0); PG8_MMA(0, 0, At, B0); PG8_BAR; PG8_SCHED;
            PG8_LDB(B1, 1, 1); PG8_STAGE(PG8_SB(1, 0), b3, voffB);
            PG8_BAR; PG8_WAIT_L(0); PG8_MMA(0, 1, At, B1); PG8_BAR;
            PG8_LDA(At, 1, 1); PG8_STAGE(PG8_SA(1, 0), a3, voffA);
            PG8_BAR; PG8_WAIT_L(0); PG8_MMA(1, 0, At, B0); PG8_BAR; PG8_SCHED;
            PG8_STAGE(PG8_SB(1, 1), b3 + hstep, voffB);
            PG8_WAIT_V(6); PG8_BAR; PG8_MMA(1, 1, At, B1); PG8_BAR;
            }
        }
        if constexpr (ALIGN_EPI) { if (wr == 0) PG8_BAR; }
        if constexpr (!Epi::AFTER_DRAIN) { E(acc, cur, wr, wc, fr, fq); S.done(cur); }
        if (!has_next) break;
#pragma unroll
        for (int a = 0; a < 2; ++a)
#pragma unroll
            for (int b = 0; b < 2; ++b)
#pragma unroll
                for (int m = 0; m < 4; ++m)
#pragma unroll
                    for (int n = 0; n < 2; ++n) acc[a][b][m][n] = (f32x4){0.f, 0.f, 0.f, 0.f};
        cur = nxt; cA = nA; cB = nB; ++ui;
        if constexpr (GATHER) {
#pragma unroll
            for (int _h = 0; _h < 2; ++_h)
#pragma unroll
                for (int _i = 0; _i < 2; ++_i) gC[_h][_i] = gN[_h][_i]; }
        if constexpr (ALIGN_EPI) { if (wr == 1) PG8_BAR; }
    }
    PG8_WAIT_V(0);
    if constexpr (!ALIGN_EPI) { if (wr == 0) PG8_BAR; }
    PG8_BAR;
    if constexpr (Epi::AFTER_DRAIN) { E.fused(acc, cur, wr, wc, fr, fq, lds, wid, lane); S.done(cur); }
#undef PG8_SA
#undef PG8_SB
#undef PG8_STAGE
#undef PG8_STAGE_A
#undef PG8_GLOOK
#undef PG8_LDA
#undef PG8_LDB
#undef PG8_MMA
#undef PG8_WAIT_V
#undef PG8_WAIT_L
#undef PG8_BAR
#undef PG8_SCHED
}
}

#define XB_TMO      128
#define XB_XCNT(j)  (256  + 64 * (j))
#define XB_XSUB(j)  (1280 + 64 * (j))
#define XB_XGEN(j)  (2304 + 64 * (j))
#define XB_TOP      3328
#define XB_TOPGEN   3392
#define XCD_BAR_WORDS 3456
#define XB_SPIN_CAP (1u << 18)

__device__ __forceinline__ unsigned xb_ld(unsigned* p)              { return __hip_atomic_load(p, __ATOMIC_RELAXED, __HIP_MEMORY_SCOPE_AGENT); }
__device__ __forceinline__ unsigned xb_add(unsigned* p, unsigned v) { return __hip_atomic_fetch_add(p, v, __ATOMIC_RELAXED, __HIP_MEMORY_SCOPE_AGENT); }
__device__ __forceinline__ unsigned xb_xcc_id() { return (unsigned)__builtin_amdgcn_s_getreg((3 << 11) | 20) & 0xFu; }
#define XB_SPIN(cond, bar) do { unsigned _sp = 0; while (cond) { __builtin_amdgcn_s_sleep(1); \
    if ((++_sp & 255u) == 0u) { if (xb_ld(&(bar)[XB_TMO])) break; if (_sp > XB_SPIN_CAP) { atomicAdd(&(bar)[XB_TMO], 1u); break; } } } } while (0)

struct XcdBarrier {
    unsigned* bar; unsigned x;
    volatile LAS unsigned* st;
};

__device__ __forceinline__ XcdBarrier xcd_barrier_post(unsigned* bar, volatile LAS unsigned* st) {
    XcdBarrier b; b.bar = bar; b.x = xb_xcc_id(); b.st = st;
    if (threadIdx.x == 0) (void)xb_add(&bar[XB_XCNT(b.x)], 1u);
    return b;
}
__device__ __forceinline__ void xcd_barrier_complete(unsigned* bar, unsigned x, unsigned& nloc, unsigned& nx) {
    const unsigned G = gridDim.x * gridDim.y * gridDim.z;
    unsigned sum, cnt, mine, sp = 0u;
    for (;;) {
        sum = 0u; cnt = 0u; mine = 0u;
#pragma unroll
        for (unsigned j = 0; j < 16; ++j) { const unsigned c = xb_ld(&bar[XB_XCNT(j)]); sum += c; cnt += (c > 0u) ? 1u : 0u; mine = (j == x) ? c : mine; }
        if (sum == G) break;
        __builtin_amdgcn_s_sleep(1);
        if ((++sp & 255u) == 0u) { if (xb_ld(&bar[XB_TMO])) break; if (sp > XB_SPIN_CAP) { atomicAdd(&bar[XB_TMO], 1u); break; } }
    }
    nloc = mine > 0u ? mine : 1u; nx = cnt > 0u ? cnt : 1u;
}

__device__ __forceinline__ void xcd_barrier(const XcdBarrier& b) {
    asm volatile("s_waitcnt vmcnt(0)" ::: "memory");
    __syncthreads();
    if (threadIdx.x == 0) {
        unsigned* bar = b.bar;
        __builtin_amdgcn_s_waitcnt(0);
        unsigned nloc = b.st[0], nx = b.st[1];
        if (nloc == 0u) { xcd_barrier_complete(bar, b.x, nloc, nx); b.st[0] = nloc; b.st[1] = nx; }
        const unsigned old = xb_add(&bar[XB_XSUB(b.x)], 1u);
        const unsigned gen = old / nloc;
        if (old + 1u == (gen + 1u) * nloc) {
            __builtin_amdgcn_fence(__ATOMIC_RELEASE, "agent");
            asm volatile("s_waitcnt vmcnt(0)" ::: "memory");
            const unsigned og = xb_add(&bar[XB_TOP], 1u);
            const unsigned tg = og / nx;
            if (og + 1u == (tg + 1u) * nx) xb_add(&bar[XB_TOPGEN], 1u);
            else XB_SPIN(xb_ld(&bar[XB_TOPGEN]) == tg, bar);
            __builtin_amdgcn_fence(__ATOMIC_ACQUIRE, "agent");
            xb_add(&bar[XB_XGEN(b.x)], 1u);
            asm volatile("s_waitcnt vmcnt(0)" ::: "memory");
        } else {
            XB_SPIN(xb_ld(&bar[XB_XGEN(b.x)]) == gen, bar);
            __builtin_amdgcn_fence(__ATOMIC_ACQUIRE, "agent");
            asm volatile("s_waitcnt vmcnt(0)" ::: "memory");
        }
    }
    __syncthreads();
}

constexpr int NWAVES = 8;
constexpr int RING_BYTES = 131072, LDSCTL_OFF = RING_BYTES, MISC_OFF = LDSCTL_OFF + 320, TILEE_OFF = LDSCTL_OFF + 1024, PS_OFF = LDSCTL_OFF + 2048;
constexpr int LDS_BYTES = 147456;
constexpr int NPHASE = 9;

struct Frame {
    LAS unsigned char* lds; volatile LAS unsigned* MISC; unsigned* ctl;
    int tid, lane, wave, vcu, G;
};

__device__ __forceinline__ void moe_tables(Frame& F) {
    LAS int* ps = (LAS int*)(F.lds + PS_OFF); LAS int* te = (LAS int*)(F.lds + TILEE_OFF);
    if (F.wave == 0) {
        const int e = F.lane & 31;
        const int nt = (int)((__hip_atomic_load(F.ctl + CW_CNT + 64 * e, __ATOMIC_RELAXED, __HIP_MEMORY_SCOPE_AGENT) + 255u) >> 8);
        int inc = nt;
#pragma unroll
        for (int o = 1; o < 32; o <<= 1) { const int v = __shfl_up(inc, o, 32); if (e >= o) inc += v; }
        if (F.lane < 32) { ps[e] = inc - nt; if (e == 31) ps[32] = inc; for (int t = inc - nt; t < inc; ++t) te[t] = e; }
    }
    __syncthreads();
}

__device__ __forceinline__ void p0_prologue(Frame& F, const Ptrs& p) {
    float* scr = (float*)(F.lds + F.wave * 8704);
    const int lane = F.lane;
    const int gw = F.vcu * NWAVES + F.wave, NGW = F.G * NWAVES;
    bf16* Wt_in = (bf16*)(p.ws + WS_WIN); bf16* Wt_out = (bf16*)(p.ws + WS_WOUT); bf16* Wgu = (bf16*)(p.ws + WS_WGU); bf16* Wd = (bf16*)(p.ws + WS_WD);
    constexpr int I_IN = (D / 64) * (DIN / 32), I_OUT = (D / 64) * (D / 32), I_G = (D / 64) * (DEXP / 32), I_DN = (DEXP / 64) * (D / 32);
    constexpr int NITEMS = I_IN + I_OUT + NEXP * (2 * I_G + I_DN);
    for (int it = gw; it < NITEMS; it += NGW) {
        int r = it;
        if (r < I_IN) { const int nblk = DIN / 32, kb = r / nblk, nb = r % nblk; transpose_item(p.w_in, D, DIN, Wt_in, 64 * kb, 32 * nb, win_row_of_col(32 * nb), scr, lane); continue; } r -= I_IN;
        if (r < I_OUT) { const int nblk = D / 32, kb = r / nblk, nb = r % nblk; transpose_item(p.w_out, D, D, Wt_out, 64 * kb, 32 * nb, 32 * nb, scr, lane); continue; } r -= I_OUT;
        const int e = r / (2 * I_G + I_DN); r -= e * (2 * I_G + I_DN);
        if (r < 2 * I_G) { const int up = r / I_G; r -= up * I_G; const int nblk = DEXP / 32, kb = r / nblk, nb = r % nblk; const int c0 = 32 * nb;
            transpose_item((up ? p.w_up : p.w_gate) + (size_t)e * D * DEXP, D, DEXP, Wgu + (size_t)e * 1024 * D, 64 * kb, c0, 256 * (c0 >> 7) + 128 * up + (c0 & 127), scr, lane); continue; }
        r -= 2 * I_G;
        { const int nblk = D / 32, kb = r / nblk, nb = r % nblk; transpose_item(p.w_down + (size_t)e * DEXP * D, DEXP, D, Wd + (size_t)e * D * DEXP, 64 * kb, 32 * nb, 32 * nb, scr, lane); }
    }
    bf16* A = (bf16*)(p.ws + WS_R2);
    for (int m = gw; m < MROWS; m += NGW) {
        u32x2* o8 = (u32x2*)(A + (size_t)m * D) + lane;
        if (m >= NTOK + NMETA) {
#pragma unroll
            for (int j = 0; j < 4; ++j) o8[64 * j] = (u32x2){0u, 0u};
            continue; }
        const float* xrow = (m < NTOK) ? p.x + (size_t)m * D : p.meta + (size_t)(m - NTOK) * D;
        const f32x4* xr = (const f32x4*)xrow + lane;
        f32x4 v[4]; float s = 0.f;
#pragma unroll
        for (int j = 0; j < 4; ++j) { v[j] = xr[64 * j]; s += (v[j].x * v[j].x + v[j].y * v[j].y) + (v[j].z * v[j].z + v[j].w * v[j].w); }
        const float rstd = 1.f / sqrtf(wave_sum(s) * (1.f / D) + EPS);
#pragma unroll
        for (int j = 0; j < 4; ++j) { const f32x4 g = ((const f32x4*)p.g1)[lane + 64 * j];
            o8[64 * j] = (u32x2){pk2(v[j].x * rstd * g.x, v[j].y * rstd * g.y), pk2(v[j].z * rstd * g.z, v[j].w * rstd * g.w)}; }
    }
    if (blockIdx.x == 0) {
        float* sm = (float*)(p.ws + WS_SM);
        for (int i = F.tid; i < 12 * 128; i += NWAVES * 64) { const int hd = i >> 7, dist = i & 127; sm[i] = p.rel_bias[t5_bucket(dist) * 12 + hd] * LOG2E; }
        if (F.tid < 64) { const int l = F.tid; const float a = wave_sum(p.lq1[l] * p.lk1[l]), b = wave_sum(p.lq2[l] * p.lk2[l]); if (l == 0) sm[SM_LAM] = expf(a) - expf(b) + 0.2f; }
    }
}

__device__ __forceinline__ void p4_router(Frame& F, const Ptrs& p) {
    const int lane = F.lane, w = F.wave, r = lane & 15, kq = lane >> 4;
    LAS float* part = (LAS float*)(F.lds);
    LAS float* pss = (LAS float*)(F.lds + 24576);
    LAS float* logit = (LAS float*)(F.lds + 25600);
    LAS float* rstd_s = (LAS float*)(F.lds + 38400);
    LAS unsigned* lcnt = (LAS unsigned*)(F.lds + 38912);
    const int k0 = 128 * w + 32 * kq;
    float bw[3][32], g2v[32];
#pragma unroll
    for (int j = 0; j < 32; ++j) { const int k = k0 + j; const float g = p.g2[k]; g2v[j] = g;
        bw[0][j] = g * (r < 4 ? p.w_group[k * 4 + r] : p.w_router[k * 32 + r - 4]);
        bw[1][j] = g * p.w_router[k * 32 + 12 + r];
        bw[2][j] = (r < 4) ? g * p.w_router[k * 32 + 28 + (r & 3)] : 0.f; }
    bf16* T = (bf16*)(p.ws + WS_R1);
    unsigned* ctl = F.ctl;
    for (int grp = F.vcu; grp < NTOK / 64; grp += F.G) {
        const int tok0 = grp * 64;
        if (F.tid < 64) lcnt[F.tid] = 0u;
        for (int ps_ = 0; ps_ < 4; ++ps_) {
            const int row = tok0 + 16 * ps_ + r;
            const f32x4* hp = (const f32x4*)(p.out + (size_t)row * D + k0);
            f32x4 a4[8];
#pragma unroll
            for (int j = 0; j < 8; ++j) a4[j] = hp[j];
            float ss = 0.f; f32x4 acc[3] = {(f32x4){0.f, 0.f, 0.f, 0.f}, (f32x4){0.f, 0.f, 0.f, 0.f}, (f32x4){0.f, 0.f, 0.f, 0.f}};
#pragma unroll
            for (int j = 0; j < 32; ++j) { const float av = a4[j >> 2][j & 3]; ss += av * av;
#pragma unroll
                for (int nb = 0; nb < 3; ++nb) acc[nb] = __builtin_amdgcn_mfma_f32_16x16x4f32(av, bw[nb][j], acc[nb], 0, 0, 0); }
            ss += __shfl_xor(ss, 16); ss += __shfl_xor(ss, 32);
            if (ps_ > 0) __syncthreads();
            if (kq == 0) pss[w * 16 + r] = ss;
#pragma unroll
            for (int nb = 0; nb < 3; ++nb)
#pragma unroll
                for (int i = 0; i < 4; ++i) part[(w * 16 + kq * 4 + i) * 48 + nb * 16 + r] = acc[nb][i];
            __syncthreads();
            if (F.tid < 16) { float s2 = 0.f;
#pragma unroll
                for (int ww = 0; ww < 8; ++ww) s2 += pss[ww * 16 + F.tid];
                rstd_s[F.tid] = 1.f / sqrtf(s2 * (1.f / D) + EPS); }
            __syncthreads();
            for (int idx = F.tid; idx < 16 * 36; idx += NWAVES * 64) { const int rr = idx / 36, c = idx - rr * 36; float v = 0.f;
#pragma unroll
                for (int ww = 0; ww < 8; ++ww) v += part[(ww * 16 + rr) * 48 + c];
                logit[(16 * ps_ + rr) * 49 + c] = v * rstd_s[rr] + (c < 4 ? p.b_group[c] : p.b_router[c - 4]); }
            { const float rs = rstd_s[r]; u32x4 o4[4];
#pragma unroll
              for (int q = 0; q < 4; ++q) { const f32x4 x0 = a4[2 * q], x1 = a4[2 * q + 1];
                  o4[q] = (u32x4){pk2(x0[0] * rs * g2v[8 * q], x0[1] * rs * g2v[8 * q + 1]), pk2(x0[2] * rs * g2v[8 * q + 2], x0[3] * rs * g2v[8 * q + 3]),
                                  pk2(x1[0] * rs * g2v[8 * q + 4], x1[1] * rs * g2v[8 * q + 5]), pk2(x1[2] * rs * g2v[8 * q + 6], x1[3] * rs * g2v[8 * q + 7])}; }
              u32x4* tp = (u32x4*)(T + (size_t)row * D + k0);
#pragma unroll
              for (int q = 0; q < 4; ++q) tp[q] = o4[q]; }
        }
        __syncthreads();
        if (w == 0) {
            const LAS float* lg = logit + lane * 49;
            float gl[4];
#pragma unroll
            for (int c = 0; c < 4; ++c) gl[c] = lg[c];
            int g = 0; float gm = gl[0];
#pragma unroll
            for (int c = 1; c < 4; ++c) if (gl[c] > gm) { gm = gl[c]; g = c; }
            float den = 0.f;
#pragma unroll
            for (int c = 0; c < 4; ++c) den += expf(gl[c] - gm);
            const float g_w = 1.f / den;
            float el[8];
#pragma unroll
            for (int c = 0; c < 8; ++c) el[c] = lg[4 + 8 * g + c];
            int j0 = 0; float l0 = el[0];
#pragma unroll
            for (int c = 1; c < 8; ++c) if (el[c] > l0) { l0 = el[c]; j0 = c; }
            int j1 = -1; float l1 = -3.0e38f;
#pragma unroll
            for (int c = 0; c < 8; ++c) if (c != j0 && el[c] > l1) { l1 = el[c]; j1 = c; }
            const float e1 = expf(l1 - l0), ga = g_w / (1.f + e1), gb = g_w * e1 / (1.f + e1);
            const int ea = g * 8 + j0, eb = g * 8 + j1, tok = tok0 + lane;
            const unsigned ra = __hip_atomic_fetch_add(lcnt + ea, 1u, __ATOMIC_RELAXED, __HIP_MEMORY_SCOPE_WORKGROUP), rb = __hip_atomic_fetch_add(lcnt + eb, 1u, __ATOMIC_RELAXED, __HIP_MEMORY_SCOPE_WORKGROUP);
            asm volatile("s_waitcnt vmcnt(0) lgkmcnt(0)" ::: "memory");
            if (lane < 32) { const unsigned n = lcnt[lane]; lcnt[32 + lane] = n ? atomicAdd(&ctl[CW_CNT + 64 * lane], n) : 0u; }
            asm volatile("s_waitcnt vmcnt(0) lgkmcnt(0)" ::: "memory");
            const unsigned pa = lcnt[32 + ea] + ra, pb = lcnt[32 + eb] + rb;
            unsigned* ep = (unsigned*)(p.ws + WS_TOK + TOK_EP); unsigned* ltok = (unsigned*)(p.ws + WS_LIST); float* lgate = (float*)(p.ws + WS_LIST + (size_t)NEXP * LISTCAP * 4);
            ep[2 * tok] = ((unsigned)ea << 20) | pa; ep[2 * tok + 1] = ((unsigned)eb << 20) | pb;
            ltok[(size_t)ea * LISTCAP + pa] = (unsigned)tok; ltok[(size_t)eb * LISTCAP + pb] = (unsigned)tok;
            lgate[(size_t)ea * LISTCAP + pa] = ga; lgate[(size_t)eb * LISTCAP + pb] = gb;
        }
        __syncthreads();
    }
}

__device__ __forceinline__ void p8_combine(Frame& F, const Ptrs& p) {
    const LAS int* ps = (const LAS int*)(F.lds + PS_OFF);
    const int lane = F.lane, gw = F.vcu * NWAVES + F.wave, NGW = F.G * NWAVES;
    const unsigned* ep = (const unsigned*)(p.ws + WS_TOK + TOK_EP); const bf16* Y = (const bf16*)(p.ws + WS_R1);
    for (int tok = gw; tok < NTOK; tok += NGW) {
        const unsigned r0 = ep[2 * tok], r1 = ep[2 * tok + 1];
        const int s0 = ps[r0 >> 20] * 256 + (int)(r0 & 0xfffffu), s1 = ps[r1 >> 20] * 256 + (int)(r1 & 0xfffffu);
        f32x4* hr = (f32x4*)(p.out + (size_t)tok * D) + lane;
        const u32x2* y0 = (const u32x2*)(Y + (size_t)s0 * D) + lane; const u32x2* y1 = (const u32x2*)(Y + (size_t)s1 * D) + lane;
#pragma unroll
        for (int j = 0; j < 4; ++j) { f32x4 v = hr[64 * j]; const u32x2 a = y0[64 * j], b = y1[64 * j];
            v.x += bf2f(a.x & 0xffff) + bf2f(b.x & 0xffff); v.y += bf2f(a.x >> 16) + bf2f(b.x >> 16); v.z += bf2f(a.y & 0xffff) + bf2f(b.y & 0xffff); v.w += bf2f(a.y >> 16) + bf2f(b.y >> 16);
            hr[64 * j] = v; }
    }
}


namespace att {
typedef short bf16x8 __attribute__((ext_vector_type(8)));
typedef short s16x4 __attribute__((ext_vector_type(4)));
typedef float f32x16 __attribute__((ext_vector_type(16)));
constexpr int SLOTB = 32768, K1_OFF = 8192, V_OFF = 16384;
constexpr int WSF_OFF = RING_BYTES - 2048;
constexpr int STG_BYTES = 17408;
constexpr int BT_OFF = LDSCTL_OFF + 4096;
constexpr float THR = 8.f;
__device__ __forceinline__ int crow(int r, int hi) { return (r & 3) + 8 * (r >> 2) + 4 * hi; }
__device__ __forceinline__ s16x4 vtr(const LAS unsigned char* p) { typedef short v4i16_t __attribute__((ext_vector_type(4))); return __builtin_bit_cast(s16x4, __builtin_amdgcn_ds_read_tr16_b64_v4i16((LAS v4i16_t*)p)); }
__device__ __forceinline__ unsigned cvtpk(float lo, float hi) { typedef float f2 __attribute__((ext_vector_type(2))); typedef __bf16 b2 __attribute__((ext_vector_type(2))); f2 v = {lo, hi}; b2 b = __builtin_convertvector(v, b2); return __builtin_bit_cast(unsigned, b); }

template <bool DIFF>
__device__ __forceinline__ void attn_unit(Frame& F, const Ptrs& p, int b, int hh, int q0) {
    constexpr int NDH = DIFF ? 4 : 2;
    const bf16* P = (const bf16*)(p.ws + WS_R1); bf16* mix = (bf16*)(p.ws + WS_R2);
    LAS unsigned char* lds = F.lds;
    const int lane = F.lane, r32 = lane & 31, hi = lane >> 5, w = F.wave;
    const int m = DIFF ? (w >> 2) : 0;
    const int r0 = DIFF ? q0 + 32 * (w & 3) : q0 + 32 * (w & 1);
    const int hq = DIFF ? hh : hh * 4 + (w >> 1);
    const int qcol = DIFF ? C_DQ + hh * 128 + m * 64 : C_SQ + hq * 64;
    const int kcol = DIFF ? C_DK + hh * 128 : C_SK + hh * 64;
    const int vcol = DIFF ? C_DV + hh * 128 : C_SV + hh * 64;
    const LAS float* btab = (const LAS float*)(lds + BT_OFF) + (DIFF ? hh : 4 + hq) * 128;
    LAS float* wsf = (LAS float*)(lds + WSF_OFF) + w * 64;
    const int tq = r0 + r32;
    const int tt_first = DIFF ? 0 : ((q0 >> 6) >= 2 ? (q0 >> 6) - 2 : 0), tt_last = DIFF ? (q0 >> 6) + 1 : (q0 >> 6);
    const int NT = 2 + tt_last - tt_first;
    auto dma = [&](int i, int s) {
        const size_t rowbase = (i == 0) ? (size_t)NTOK : (size_t)b * SEQ + 64 * (tt_first + i - 1);
        LAS unsigned char* sl = lds + s * SLOTB;
        const bf16* ks = P + (rowbase + lane) * DIN + kcol + w * 8;
        __builtin_amdgcn_global_load_lds((const unsigned*)ks, (LAS unsigned*)(sl + w * 1024), 16, 0, 0);
        if (DIFF) __builtin_amdgcn_global_load_lds((const unsigned*)(ks + 64), (LAS unsigned*)(sl + K1_OFF + w * 1024), 16, 0, 0);
#pragma unroll
        for (int j = 0; j < (DIFF ? 2 : 1); ++j) { const int id = w + 8 * j, dh = id >> 2, kg = id & 3;
            const bf16* vs = P + (rowbase + 16 * kg + (lane >> 2)) * DIN + vcol + dh * 32 + (lane & 3) * 8;
            __builtin_amdgcn_global_load_lds((const unsigned*)vs, (LAS unsigned*)(sl + V_OFF + id * 1024), 16, 0, 0); }
    };
    dma(0, 0);
    bf16x8 qr[4];
    { const bf16* qp = P + ((size_t)b * SEQ + tq) * DIN + qcol + hi * 8;
#pragma unroll
      for (int d0 = 0; d0 < 4; ++d0) qr[d0] = *(const bf16x8*)(qp + d0 * 16); }
    float mhat = 0.f, l_reg = 0.f;
    f32x16 o[NDH];
#pragma unroll
    for (int dh = 0; dh < NDH; ++dh) o[dh] = f32x16{};
    f32x16 negm = f32x16{};
    const int koff = (DIFF && m) ? K1_OFF : 0;
    for (int i = 0; i < NT; ++i) {
        asm volatile("s_waitcnt vmcnt(0)" ::: "memory");
        __syncthreads();
        if (i + 1 < NT) dma(i + 1, (i + 1) & 1);
        const int tt = tt_first + i - 1;
        const int tok0 = 64 * tt;
        if (i > 0 && tok0 > r0 + 31) continue;
        if (!DIFF && i > 0 && tok0 + 63 < r0 - 127) continue;
        const LAS unsigned char* sl = lds + (i & 1) * SLOTB;
        f32x16 p0 = negm, p1 = negm;
        { const LAS unsigned char* kb = sl + koff + hi * 1024 + r32 * 16;
#pragma unroll
          for (int d0 = 0; d0 < 4; ++d0) { const bf16x8 a0 = *(const LAS bf16x8*)(kb + d0 * 2048), a1 = *(const LAS bf16x8*)(kb + d0 * 2048 + 512);
              p0 = __builtin_amdgcn_mfma_f32_32x32x16_bf16(a0, qr[d0], p0, 0, 0, 0); p1 = __builtin_amdgcn_mfma_f32_32x32x16_bf16(a1, qr[d0], p1, 0, 0, 0); } }
        const bool meta = (i == 0);
        const bool near_ = meta || (DIFF ? (tok0 + 63 >= r0 - 127) : true);
        if (near_) {
            const int delta = meta ? 16 + tq : tq - tok0;
#pragma unroll
            for (int r = 0; r < 16; ++r) { const int kk = crow(r, hi); const int d0_ = delta - kk, d1_ = d0_ - 32;
                const float b0 = btab[min(max(d0_, 0), 127)], b1 = btab[min(max(d1_, 0), 127)];
                bool ok0, ok1;
                if (meta) { ok0 = kk < 16; ok1 = false; }
                else if (DIFF) { ok0 = d0_ >= 0; ok1 = d1_ >= 0; }
                else { ok0 = d0_ >= 0 && d0_ < 128; ok1 = d1_ >= 0 && d1_ < 128; }
                p0[r] = ok0 ? p0[r] + b0 : -INFINITY; p1[r] = ok1 ? p1[r] + b1 : -INFINITY; }
        }
        float rm = fmaxf(p0[0], p1[0]);
#pragma unroll
        for (int r = 1; r < 16; ++r) rm = fmaxf(rm, fmaxf(p0[r], p1[r]));
        { auto rr = __builtin_amdgcn_permlane32_swap(__float_as_uint(rm), __float_as_uint(rm), false, false); rm = fmaxf(__uint_as_float(rr[0]), __uint_as_float(rr[1])); }
        if (__any(rm > THR) || i == 0) {
            const float dl = (i == 0) ? rm : fmaxf(rm, 0.f);
            mhat += dl;
#pragma unroll
            for (int r = 0; r < 16; ++r) { p0[r] -= dl; p1[r] -= dl; negm[r] = -mhat; }
            const float f = __builtin_amdgcn_exp2f(-dl);
            l_reg = (i == 0) ? 0.f : l_reg * f;
            if (i > 0) {
                if (hi == 0) wsf[r32] = f;
                asm volatile("s_waitcnt lgkmcnt(0)" ::: "memory");
#pragma unroll
                for (int g = 0; g < 4; ++g) { const f32x4 fv = *(const LAS f32x4*)(wsf + 8 * g + 4 * hi);
#pragma unroll
                    for (int dh = 0; dh < NDH; ++dh)
#pragma unroll
                        for (int j = 0; j < 4; ++j) o[dh][4 * g + j] *= fv[j]; }
            }
        }
        float sacc = 0.f;
#pragma unroll
        for (int r = 0; r < 16; ++r) { p0[r] = __builtin_amdgcn_exp2f(p0[r]); p1[r] = __builtin_amdgcn_exp2f(p1[r]); sacc += p0[r] + p1[r]; }
        l_reg += sacc;
        u32x4 pw[4];
#pragma unroll
        for (int j = 0; j < 4; ++j) { pw[0][j] = cvtpk(p0[2 * j], p0[2 * j + 1]); pw[1][j] = cvtpk(p0[8 + 2 * j], p0[8 + 2 * j + 1]); pw[2][j] = cvtpk(p1[2 * j], p1[2 * j + 1]); pw[3][j] = cvtpk(p1[8 + 2 * j], p1[8 + 2 * j + 1]); }
        const LAS unsigned char* vb = sl + V_OFF + ((lane >> 4) & 1) * 32 + (lane & 3) * 8 + (4 * hi + ((lane & 15) >> 2)) * 64;
#pragma unroll
        for (int dh = 0; dh < NDH; ++dh)
#pragma unroll
            for (int ks = 0; ks < 4; ++ks) { const s16x4 lo = vtr(vb + dh * 4096 + ks * 1024), hi4 = vtr(vb + dh * 4096 + ks * 1024 + 512);
                const bf16x8 vf = (bf16x8){lo[0], lo[1], lo[2], lo[3], hi4[0], hi4[1], hi4[2], hi4[3]};
                o[dh] = __builtin_amdgcn_mfma_f32_32x32x16_bf16(__builtin_bit_cast(bf16x8, pw[ks]), vf, o[dh], 0, 0, 0); }
    }
    { auto rr = __builtin_amdgcn_permlane32_swap(__float_as_uint(l_reg), __float_as_uint(l_reg), false, false); l_reg = __uint_as_float(rr[0]) + __uint_as_float(rr[1]); }
    if (!DIFF) l_reg += __builtin_amdgcn_exp2f(*((const LAS float*)(lds + BT_OFF) + 12 * 128 + hq) - mhat);
    const float lam = *((const LAS float*)(lds + BT_OFF) + 12 * 128 + 8);
    if (hi == 0) wsf[r32] = ((DIFF && m) ? lam : 1.f) / l_reg;
    asm volatile("s_waitcnt lgkmcnt(0)" ::: "memory");
    float sc[16];
#pragma unroll
    for (int g = 0; g < 4; ++g) { const f32x4 fv = *(const LAS f32x4*)(wsf + 8 * g + 4 * hi); sc[4 * g] = fv[0]; sc[4 * g + 1] = fv[1]; sc[4 * g + 2] = fv[2]; sc[4 * g + 3] = fv[3]; }
    __syncthreads();
    if (DIFF) {
        LAS float* ex = (LAS float*)(lds + (w & 3) * STG_BYTES);
        if (m) {
#pragma unroll
            for (int dh = 0; dh < NDH; ++dh)
#pragma unroll
                for (int r = 0; r < 16; ++r) ex[(dh * 16 + r) * 64 + lane] = o[dh][r] * sc[r];
        }
        __syncthreads();
        if (!m) {
#pragma unroll
            for (int dh = 0; dh < NDH; ++dh)
#pragma unroll
                for (int r = 0; r < 16; ++r) o[dh][r] = o[dh][r] * sc[r] - ex[(dh * 16 + r) * 64 + lane];
            asm volatile("s_waitcnt lgkmcnt(0)" ::: "memory");
#pragma unroll
            for (int dh = 0; dh < NDH; ++dh)
#pragma unroll
                for (int r = 0; r < 16; ++r) ex[crow(r, hi) * 132 + dh * 32 + r32] = o[dh][r];
            asm volatile("s_waitcnt lgkmcnt(0)" ::: "memory");
            const int row = lane >> 1, half = lane & 1;
            f32x4 v[16]; float ss = 0.f;
#pragma unroll
            for (int j = 0; j < 16; ++j) { v[j] = *(const LAS f32x4*)(ex + row * 132 + half * 64 + 4 * j); ss += (v[j][0] * v[j][0] + v[j][1] * v[j][1]) + (v[j][2] * v[j][2] + v[j][3] * v[j][3]); }
            ss += __shfl_xor(ss, 1);
            const float rstd = 0.8f / sqrtf(ss * (1.f / 128.f) + EPS);
            bf16* op = mix + ((size_t)b * SEQ + r0 + row) * D + hh * 128 + half * 64;
#pragma unroll
            for (int j = 0; j < 16; j += 2) { const f32x4 g0 = *(const f32x4*)(p.subg + half * 64 + 4 * j), g1 = *(const f32x4*)(p.subg + half * 64 + 4 * j + 4);
                *(u32x4*)(op + 4 * j) = (u32x4){cvtpk(v[j][0] * rstd * g0[0], v[j][1] * rstd * g0[1]), cvtpk(v[j][2] * rstd * g0[2], v[j][3] * rstd * g0[3]), cvtpk(v[j + 1][0] * rstd * g1[0], v[j + 1][1] * rstd * g1[1]), cvtpk(v[j + 1][2] * rstd * g1[2], v[j + 1][3] * rstd * g1[3])}; }
        }
    } else {
        LAS float* ex = (LAS float*)(lds + w * 8704);
#pragma unroll
        for (int dh = 0; dh < NDH; ++dh)
#pragma unroll
            for (int r = 0; r < 16; ++r) ex[crow(r, hi) * 68 + dh * 32 + r32] = o[dh][r] * sc[r];
        asm volatile("s_waitcnt lgkmcnt(0)" ::: "memory");
        const int row = lane >> 1, half = lane & 1;
        bf16* op = mix + ((size_t)b * SEQ + r0 + row) * D + 512 + hq * 64 + half * 32;
#pragma unroll
        for (int j = 0; j < 8; j += 2) { const f32x4 a = *(const LAS f32x4*)(ex + row * 68 + half * 32 + 4 * j), c = *(const LAS f32x4*)(ex + row * 68 + half * 32 + 4 * j + 4);
            *(u32x4*)(op + 4 * j) = (u32x4){cvtpk(a[0], a[1]), cvtpk(a[2], a[3]), cvtpk(c[0], c[1]), cvtpk(c[2], c[3])}; }
    }
    __syncthreads();
}

__device__ __forceinline__ void attn_phase(Frame& F, const Ptrs& p) {
    { const float* sm = (const float*)(p.ws + WS_SM); LAS float* bt = (LAS float*)(F.lds + BT_OFF);
      for (int i = F.tid; i < 12 * 128; i += NWAVES * 64) bt[i] = sm[i] - sm[(i & ~127) + 127];
      if (F.tid < 8) bt[12 * 128 + F.tid] = p.sinks[F.tid] * LOG2E - sm[(4 + F.tid) * 128 + 127];
      if (F.tid == 8) bt[12 * 128 + 8] = sm[SM_LAM]; }
    __syncthreads();
    for (int v = F.vcu; v < 256; v += F.G) { const int bh = v >> 4, s = v & 15;
        attn_unit<true>(F, p, bh >> 2, bh & 3, 128 * (31 - s)); attn_unit<true>(F, p, bh >> 2, bh & 3, 128 * s); }
    for (int u = F.vcu; u < 512; u += F.G) { const int bk = u >> 6, qb = u & 63; attn_unit<false>(F, p, bk >> 1, bk & 1, 64 * qb); }
}
}

struct Args { Ptrs p; int ph_lo, ph_hi, li, pad; };
__global__ void __launch_bounds__(NWAVES * 64, 2) mk(Args args) {
    extern __shared__ __attribute__((aligned(16))) unsigned char lds[];
    Frame F;
    F.lds = (LAS unsigned char*)lds; F.MISC = (volatile LAS unsigned*)(F.lds + MISC_OFF);
    F.tid = threadIdx.x; F.lane = F.tid & 63; F.wave = __builtin_amdgcn_readfirstlane(F.tid >> 6);
    F.G = gridDim.x; { const int bx = blockIdx.x; F.vcu = (F.G % 8 == 0) ? (bx % 8) * (F.G / 8) + bx / 8 : bx; }
    const Ptrs& p = args.p;
    F.ctl = (unsigned*)(p.ws + WS_CTL);
    for (int u = F.tid; u < (LDS_BYTES - LDSCTL_OFF) / 4; u += NWAVES * 64) ((LAS unsigned*)(F.lds + LDSCTL_OFF))[u] = 0u;
    __syncthreads();
    XcdBarrier bar = xcd_barrier_post(F.ctl + CW_BAR + args.li * XCD_BAR_WORDS, F.MISC + 8);
    const int lo = args.ph_lo, hi = args.ph_hi;
#define IN(k) (lo <= (k) && (k) < hi)
#define SEAM(k) do { if (IN(k) && IN((k) + 1)) xcd_barrier(bar); } while (0)

    if (IN(0)) { p0_prologue(F, p); SEAM(0); }
    if (IN(1)) {
        pg8::Gemm g{(const bf16*)(p.ws + WS_R2), (const bf16*)(p.ws + WS_WIN), MROWS, DIN, D}; pg8::StaticOrder S; S.init(MROWS, DIN, F.G, (int)blockIdx.x);
        pg8::EpiProj E{(bf16*)(p.ws + WS_R1), p.dqg, p.dkg, p.sqg, p.skg};
        pg8::gemm_phase<pg8::EpiProj, pg8::StaticOrder, true, true>(F.lds, g, S, E);
        SEAM(1);
    }
    if (IN(2)) { att::attn_phase(F, p); SEAM(2); }
    if (IN(3)) {
        pg8::Gemm g{(const bf16*)(p.ws + WS_R2), (const bf16*)(p.ws + WS_WOUT), NTOK, D, D}; pg8::StaticOrder S; S.init(NTOK, D, F.G, (int)blockIdx.x);
        pg8::EpiOut E{p.x, p.out};
        pg8::gemm_phase<pg8::EpiOut, pg8::StaticOrder, true, true>(F.lds, g, S, E);
        SEAM(3);
    }
    if (IN(4)) { p4_router(F, p); if (IN(6)) xcd_barrier(bar); }
    if (IN(6)) {
        moe_tables(F);
        const int ntile = *(const LAS int*)(F.lds + PS_OFF + 32 * 4);
        pg8::Gemm g{(const bf16*)(p.ws + WS_R1), (const bf16*)(p.ws + WS_WGU), ntile * 256, 1024, D};
        pg8::MoeOrder S; S.so.init(ntile * 256, 1024, F.G, (int)blockIdx.x); S.tile_e = (const LAS int*)(F.lds + TILEE_OFF); S.ps = (const LAS int*)(F.lds + PS_OFF);
        S.ltok = (const unsigned*)(p.ws + WS_LIST); S.cnt = F.ctl + CW_CNT;
        pg8::EpiGU E{(bf16*)(p.ws + WS_R2)};
        pg8::gemm_phase<pg8::EpiGU, pg8::MoeOrder, true, true, true>(F.lds, g, S, E);
        SEAM(6);
    }
    if (IN(7)) {
        moe_tables(F);
        const int ntile = *(const LAS int*)(F.lds + PS_OFF + 32 * 4);
        pg8::Gemm g{(const bf16*)(p.ws + WS_R2), (const bf16*)(p.ws + WS_WD), ntile * 256, 1024, DEXP};
        pg8::MoeOrder S; S.so.init(ntile * 256, 1024, F.G, (int)blockIdx.x); S.tile_e = (const LAS int*)(F.lds + TILEE_OFF); S.ps = (const LAS int*)(F.lds + PS_OFF);
        S.ltok = (const unsigned*)(p.ws + WS_LIST); S.cnt = F.ctl + CW_CNT;
        pg8::EpiDown E{(bf16*)(p.ws + WS_R1), (const float*)(p.ws + WS_LIST + (size_t)NEXP * LISTCAP * 4), (const LAS int*)(F.lds + PS_OFF)};
        pg8::gemm_phase<pg8::EpiDown, pg8::MoeOrder, true, true>(F.lds, g, S, E);
        SEAM(7);
    }
    if (IN(8)) { moe_tables(F); p8_combine(F, p); }
#undef IN
#undef SEAM
}

extern "C" void kernel_launch(void* const* d_in, const int* in_sizes, int n_in, void* d_out, int out_size, void* d_ws, size_t ws_size, hipStream_t stream) {
    static int grid = 0;
    if (grid == 0) {
        if (n_in != 24 || in_sizes[0] != NTOK * D || out_size != NTOK * D || ws_size < WS_END) { fprintf(stderr, "kernel_launch: unexpected shapes (n_in %d, in0 %d, out %d, ws %zu)\n", n_in, n_in > 0 ? in_sizes[0] : -1, out_size, ws_size); grid = -1; return; }
        int dev = 0, cus = 0, per_cu = 0;
        if (hipGetDevice(&dev) != hipSuccess || hipDeviceGetAttribute(&cus, hipDeviceAttributeMultiprocessorCount, dev) != hipSuccess) { grid = -1; return; }
        if (hipFuncSetAttribute((const void*)mk, hipFuncAttributeMaxDynamicSharedMemorySize, LDS_BYTES) != hipSuccess) { fprintf(stderr, "kernel_launch: hipFuncSetAttribute failed\n"); grid = -1; return; }
        if (hipOccupancyMaxActiveBlocksPerMultiprocessor(&per_cu, (const void*)mk, NWAVES * 64, LDS_BYTES) != hipSuccess || per_cu < 1) fprintf(stderr, "kernel_launch: occupancy query reports %d\n", per_cu);
        (void)hipGetLastError();
        grid = cus;
    }
    if (grid < 0) return;
    Args a{};
    const float** f = (const float**)&a.p;
    for (int i = 0; i < 24; ++i) f[i] = (const float*)d_in[i];
    a.p.out = (float*)d_out; a.p.ws = (unsigned char*)d_ws;
    (void)hipMemsetAsync((char*)d_ws + WS_CTL, 0, CTL_ZERO_BYTES, stream);
    a.ph_lo = 0; a.ph_hi = NPHASE; a.li = 0;
    hipLaunchKernelGGL(mk, dim3(grid), dim3(NWAVES * 64), LDS_BYTES, stream, a);
}
```

```cpp
#include <hip/hip_runtime.h>
#include <cstdio>
#include <cstdint>

typedef unsigned short bf16;
typedef unsigned u32x4 __attribute__((ext_vector_type(4)));
typedef unsigned u32x2 __attribute__((ext_vector_type(2)));
typedef float f32x4 __attribute__((ext_vector_type(4)));

constexpr int NB = 4, SEQ = 4096, D = 1024, NTOK = NB * SEQ, NMETA = 16;
constexpr int MROWS = NTOK + 256;
constexpr int DIN = 2304;
constexpr int C_DQ = 0, C_DK = 512, C_DV = 1024, C_SQ = 1536, C_SK = 2048, C_SV = 2176;
constexpr int NEXP = 32, DEXP = 512;
constexpr int LISTCAP = 16384;
constexpr int MAXSLOT = 40960;
constexpr float EPS = 1e-6f;
constexpr float LOG2E = 1.4426950408889634f;
constexpr float C2 = 0.125f * LOG2E;

constexpr size_t MiB = 1u << 20;
constexpr size_t WS_CTL = 0, CTL_ZERO_BYTES = 1 * MiB;
constexpr size_t WS_SM = 1 * MiB;
constexpr size_t WS_TOK = 2 * MiB;
constexpr size_t WS_WIN = 4 * MiB, WS_WOUT = 9 * MiB, WS_WGU = 12 * MiB, WS_WD = 76 * MiB;
constexpr size_t WS_R1 = 108 * MiB;
constexpr size_t WS_R2 = 188 * MiB;
constexpr size_t WS_LIST = 228 * MiB;
constexpr size_t WS_END = 232 * MiB;
constexpr int CW_BAR = 4096;
constexpr int CW_CNT = 16384;
constexpr int SM_BIASD = 0, SM_BIASS = 512, SM_LAM = 1536;
constexpr size_t TOK_EP = 0, TOK_GATE = 131072, TOK_GSLOT = 262144, TOK_TILEE = 262144 + 163840, TOK_NT = TOK_TILEE + 1024;

__device__ __forceinline__ float bf2f(bf16 v) { return __builtin_bit_cast(float, (unsigned)v << 16); }
__device__ __forceinline__ unsigned f2bf(float f) { unsigned u = __builtin_bit_cast(unsigned, f); return (u + 0x7fffu + ((u >> 16) & 1u)) >> 16; }
__device__ __forceinline__ unsigned pk2(float lo, float hi) { return f2bf(lo) | (f2bf(hi) << 16); }
__device__ __forceinline__ float wave_sum(float v) {
#pragma unroll
    for (int o = 1; o < 64; o <<= 1) v += __shfl_xor(v, o);
    return v;
}
__device__ __forceinline__ int t5_bucket(int n) {
    if (n < 16) return n;
    const int st[16] = {16, 19, 21, 24, 27, 31, 35, 40, 46, 52, 59, 67, 77, 87, 99, 113};
    int b = 15;
#pragma unroll
    for (int i = 0; i < 16; ++i) b += (n >= st[i]) ? 1 : 0;
    return b;
}
__host__ __device__ __forceinline__ int win_row_of_col(int c) { const int T = c >> 8, r = c & 255, wc = r >> 6, bj = (r >> 5) & 1, i = r & 31; return T * 256 + bj * 128 + wc * 32 + i; }

struct Ptrs {
    const float *x, *meta, *rel_bias, *g1, *w_in, *dqg, *dkg, *lq1, *lk1, *lq2, *lk2, *subg, *sqg, *skg, *sinks, *w_out, *g2, *w_group, *b_group, *w_router, *b_router, *w_gate, *w_up, *w_down;
    float* out; unsigned char* ws;
};

#define LAS __attribute__((address_space(3)))
__device__ __forceinline__ void transpose_item(const float* W, int K, int N, bf16* WT, int k0, int n0, int drow0, float* scr, int lane) {
    f32x4 v[8];
#pragma unroll
    for (int j = 0; j < 8; ++j) v[j] = *(const f32x4*)(W + (size_t)(k0 + 8 * j + (lane >> 3)) * N + n0 + 4 * (lane & 7));
#pragma unroll
    for (int j = 0; j < 8; ++j) { float* d = scr + (8 * j + (lane >> 3)) * 33 + 4 * (lane & 7); d[0] = v[j].x; d[1] = v[j].y; d[2] = v[j].z; d[3] = v[j].w; }
    asm volatile("s_waitcnt lgkmcnt(0)" ::: "memory");
    const int c = lane & 7;
#pragma unroll
    for (int j = 0; j < 4; ++j) { const int n = (lane >> 3) + 8 * j; const float* s = scr + (8 * c) * 33 + n;
        u32x4 o; o.x = pk2(s[0 * 33], s[1 * 33]); o.y = pk2(s[2 * 33], s[3 * 33]); o.z = pk2(s[4 * 33], s[5 * 33]); o.w = pk2(s[6 * 33], s[7 * 33]);
        *(u32x4*)(WT + (size_t)(drow0 + n) * K + k0 + 8 * c) = o; }
    asm volatile("s_waitcnt lgkmcnt(0)" ::: "memory");
}


namespace pg8 {
#define PG8_LAS __attribute__((address_space(3)))
typedef unsigned short bf16_t;
typedef short bf16x8 __attribute__((ext_vector_type(8)));
typedef float f32x4 __attribute__((ext_vector_type(4)));
typedef unsigned u32x4 __attribute__((ext_vector_type(4)));
constexpr int BM = 256, BK = 64, HALF = 128, HTB = HALF * BK * 2  , STAGE_BYTES = 8 * HTB, NXCD = 8, WGM = 8;

__host__ __device__ __forceinline__ int lds_byte(int r, int c) { const int st = (r >> 4) * 2 + (c >> 5), rr = r & 15, cc = c & 31, ob = rr * 64 + cc * 2; return st * 1024 + (ob ^ (((ob >> 9) & 1) << 5)); }
__host__ __device__ __forceinline__ void stage_rc(int b, int& R, int& C) { const int st = b / 1024, sb = b % 1024, swz = sb ^ (((sb >> 9) & 1) << 5); R = (st >> 1) * 16 + swz / 64; C = (st & 1) * 32 + (swz % 64) / 2; }
__host__ __device__ __forceinline__ int perm32(int rho) { const int n = rho >> 4, i = rho & 15; return 8 * (i >> 2) + 4 * n + (i & 3); }

struct Unit { int pm, pn; };
struct Gemm { const bf16_t* A; const bf16_t* Bt; int M, N, K; };

struct StaticOrder {
    int nM, nN, nwg, G, c;
    __host__ __device__ void init(int M, int N, int G_, int c_) { nM = M / BM; nN = N / BM; nwg = nM * nN; G = G_; c = c_; }
    __host__ __device__ bool next(int i, Unit& u) const {
        const long L = (long)i * G + c; if (L >= nwg) return false;
        int wgid = (int)L; { const int q = nwg / NXCD, r = nwg % NXCD, xcd = wgid % NXCD, off = wgid / NXCD; wgid = (xcd < r ? xcd * (q + 1) : r * (q + 1) + (xcd - r) * q) + off; }
        const int nig = WGM * nN, gid = wgid / nig, fm = gid * WGM, gsz = (nM - fm) < WGM ? (nM - fm) : WGM;
        u.pm = fm + ((wgid % nig) % gsz); u.pn = (wgid % nig) / gsz; return true;
    }
    __device__ __forceinline__ void a_ready(const Unit&) const {}
    __device__ __forceinline__ void done(const Unit&) const {}
};


__device__ __forceinline__ unsigned cvt_pk_bf16(float lo, float hi) { unsigned r; asm volatile("v_cvt_pk_bf16_f32 %0, %1, %2" : "=v"(r) : "v"(lo), "v"(hi)); return r; }
__device__ __forceinline__ u32x4 pack8(const f32x4 a, const f32x4 b) { u32x4 w; w.x = cvt_pk_bf16(a[0], a[1]); w.y = cvt_pk_bf16(a[2], a[3]); w.z = cvt_pk_bf16(b[0], b[1]); w.w = cvt_pk_bf16(b[2], b[3]); return w; }

struct EpiProj {
    static constexpr bool PERM = true, AFTER_DRAIN = false;
    bf16_t* P; const float *dqg, *dkg, *sqg, *skg;
    __device__ __forceinline__ void operator()(const f32x4 (&acc)[2][2][4][2], const Unit& u, int wr, int wc, int fr, int fq) const {
        const int chunk = u.pn * 4 + wc;
        bool kind = false; const float* gain = dqg; float sc = 1.f;
        if (chunk < 8) { kind = true; gain = dqg; sc = C2; } else if (chunk < 16) { kind = true; gain = dkg; } else if (chunk < 24) { kind = false; }
        else if (chunk < 32) { kind = true; gain = sqg; sc = C2; } else if (chunk < 34) { kind = true; gain = skg; }
        f32x4 gv[2][2];
#pragma unroll
        for (int bj = 0; bj < 2; ++bj)
#pragma unroll
            for (int n = 0; n < 2; ++n) gv[bj][n] = kind ? *(const f32x4*)(gain + 32 * bj + 8 * fq + 4 * n) * sc : (f32x4){1.f, 1.f, 1.f, 1.f};
        const int row0 = u.pm * BM + wr * 64 + fr, col0 = u.pn * BM + 64 * wc + 8 * fq;
#pragma unroll
        for (int ai = 0; ai < 2; ++ai)
#pragma unroll
            for (int m = 0; m < 4; ++m) {
                float ss = 0.f;
#pragma unroll
                for (int bj = 0; bj < 2; ++bj)
#pragma unroll
                    for (int n = 0; n < 2; ++n) { const f32x4 v = acc[ai][bj][m][n]; ss += (v[0] * v[0] + v[1] * v[1]) + (v[2] * v[2] + v[3] * v[3]); }
                ss += __shfl_xor(ss, 16); ss += __shfl_xor(ss, 32);
                const float rstd = kind ? 1.f / sqrtf(ss * (1.f / 64.f) + EPS) : 1.f;
                bf16_t* rowp = P + (size_t)(row0 + ai * HALF + m * 16) * DIN + col0;
#pragma unroll
                for (int bj = 0; bj < 2; ++bj) *(u32x4*)(rowp + 32 * bj) = pack8(acc[ai][bj][m][0] * gv[bj][0] * rstd, acc[ai][bj][m][1] * gv[bj][1] * rstd);
            }
    }
};
struct EpiOut {
    static constexpr bool PERM = true, AFTER_DRAIN = false;
    const float* x; float* out;
    __device__ __forceinline__ void operator()(const f32x4 (&acc)[2][2][4][2], const Unit& u, int wr, int wc, int fr, int fq) const {
        const int row0 = u.pm * BM + wr * 64 + fr, col0 = u.pn * BM + wc * 32 + 8 * fq;
#pragma unroll
        for (int ai = 0; ai < 2; ++ai)
#pragma unroll
            for (int m = 0; m < 4; ++m)
#pragma unroll
                for (int bj = 0; bj < 2; ++bj) { const size_t o = (size_t)(row0 + ai * HALF + m * 16) * D + col0 + bj * HALF;
                    const f32x4 x0 = *(const f32x4*)(x + o), x1 = *(const f32x4*)(x + o + 4);
                    *(f32x4*)(out + o) = x0 + acc[ai][bj][m][0]; *(f32x4*)(out + o + 4) = x1 + acc[ai][bj][m][1]; }
    }
};
struct EpiGU {
    static constexpr bool PERM = true, AFTER_DRAIN = false;
    bf16_t* H;
    __device__ __forceinline__ void operator()(const f32x4 (&acc)[2][2][4][2], const Unit& u, int wr, int wc, int fr, int fq) const {
        const int pnl = u.pn & 3, row0 = u.pm * BM + wr * 64 + fr, col0 = pnl * 128 + wc * 32 + 8 * fq;
#pragma unroll
        for (int ai = 0; ai < 2; ++ai)
#pragma unroll
            for (int m = 0; m < 4; ++m) { f32x4 v[2];
#pragma unroll
                for (int n = 0; n < 2; ++n)
#pragma unroll
                    for (int i = 0; i < 4; ++i) { const float g = acc[ai][0][m][n][i]; v[n][i] = g * __builtin_amdgcn_rcpf(1.f + __builtin_amdgcn_exp2f(-LOG2E * g)) * acc[ai][1][m][n][i]; }
                *(u32x4*)(H + (size_t)(row0 + ai * HALF + m * 16) * DEXP + col0) = pack8(v[0], v[1]); }
    }
};
struct EpiDown {
    static constexpr bool PERM = true, AFTER_DRAIN = false;
    bf16_t* Y; const float* lgate; const PG8_LAS int* ps;
    __device__ __forceinline__ void operator()(const f32x4 (&acc)[2][2][4][2], const Unit& u, int wr, int wc, int fr, int fq) const {
        const int pnl = u.pn & 3, e = u.pn >> 2, row0 = u.pm * BM + wr * 64 + fr, col0 = pnl * BM + wc * 32 + 8 * fq;
        const float* gl = lgate + (size_t)e * LISTCAP + (u.pm - ps[e]) * BM + wr * 64 + fr;
#pragma unroll
        for (int ai = 0; ai < 2; ++ai)
#pragma unroll
            for (int m = 0; m < 4; ++m) { const int r = row0 + ai * HALF + m * 16; const float g = gl[ai * HALF + m * 16];
#pragma unroll
                for (int bj = 0; bj < 2; ++bj) *(u32x4*)(Y + (size_t)r * D + col0 + bj * HALF) = pack8(acc[ai][bj][m][0] * g, acc[ai][bj][m][1] * g); }
    }
};
struct MoeOrder {
    StaticOrder so; const PG8_LAS int* tile_e; const PG8_LAS int* ps; const unsigned* ltok; const unsigned* cnt;
    __device__ __forceinline__ bool next(int i, Unit& u) const { if (!so.next(i, u)) return false; u.pn += 4 * tile_e[u.pm]; return true; }
    __device__ __forceinline__ unsigned row_off(const Unit& u, int row) const { const int e = u.pn >> 2, idx = (u.pm - ps[e]) * BM + row;
        const unsigned n = cnt[64 * e]; const unsigned tok = ((unsigned)idx < n) ? ltok[(size_t)e * LISTCAP + idx] : 0u; return tok * (unsigned)(D * 2); }
    __device__ __forceinline__ void a_ready(const Unit&) const {}
    __device__ __forceinline__ void done(const Unit&) const {}
};

template <class Epi, class Sched, bool ALIGN_EPI = false, bool SP2 = false, bool GATHER = false>
__device__ __forceinline__ void gemm_phase(PG8_LAS unsigned char* lds, const Gemm g, const Sched& S, const Epi& E) {
    const int tid = threadIdx.x, wid = __builtin_amdgcn_readfirstlane(tid >> 6), lane = tid & 63, wr = wid >> 2, wc = wid & 3, fr = lane & 15, fq = lane >> 4;
    const int K = g.K, nt = K / BK;
    unsigned voffA[2], voffB[2];
#pragma unroll
    for (int i = 0; i < 2; ++i) { int R, C; stage_rc(tid * 16 + i * 8192, R, C); const int Rb = Epi::PERM ? ((R & ~31) + perm32(R & 31)) : R;
        voffA[i] = (unsigned)(R * K + C) * 2u; voffB[i] = (unsigned)(Rb * K + C) * 2u; }
    static_assert(!GATHER || SP2, "GATHER is written for the SP2 loop");
    unsigned gC[2][2], gN[2][2]; int gR[2], gCol[2];
#pragma unroll
    for (int i = 0; i < 2; ++i) { int R, C; stage_rc(tid * 16 + i * 8192, R, C); gR[i] = R; gCol[i] = C * 2; }
#define PG8_GLOOK(dst, u) do { _Pragma("unroll") for (int _h = 0; _h < 2; ++_h) _Pragma("unroll") for (int _i = 0; _i < 2; ++_i) dst[_h][_i] = S.row_off(u, _h * HALF + gR[_i]) + (unsigned)gCol[_i]; } while (0)
#define PG8_STAGE_A(bufoff, gbase, h, nx) do { if constexpr (GATHER) { _Pragma("unroll") for (int _i = 0; _i < 2; ++_i) \
        __builtin_amdgcn_global_load_lds((const unsigned*)((const char*)(gbase) + ((nx) ? gN[h][_i] : gC[h][_i])), (PG8_LAS unsigned*)(lds + (bufoff) + ldsw + _i * 8192), 16, 0, 0); } \
    else { PG8_STAGE(bufoff, (gbase) + (h) * hstep, voffA); } } while (0)
    const size_t kstep = (size_t)(BK * 2);
    const size_t hstep = (size_t)HALF * K * 2;
    const size_t tstep = 2 * hstep;
    const unsigned ldsw = (unsigned)wid * 1024u;
    const int aoff = lds_byte(wr * 64 + fr, fq * 8), boff = lds_byte(wc * 32 + fr, fq * 8);
#define PG8_SA(b, h) (((b) * 2 + (h)) * HTB)
#define PG8_SB(b, h) ((4 + (b) * 2 + (h)) * HTB)
#define PG8_STAGE(bufoff, gbase, voff) do { _Pragma("unroll") for (int _i = 0; _i < 2; ++_i) \
        __builtin_amdgcn_global_load_lds((const unsigned*)((const char*)(gbase) + (voff)[_i]), (PG8_LAS unsigned*)(lds + (bufoff) + ldsw + _i * 8192), 16, 0, 0); } while (0)
#define PG8_LDA(dst, b, h) do { _Pragma("unroll") for (int m = 0; m < 4; ++m) _Pragma("unroll") for (int k = 0; k < 2; ++k) dst[m][k] = *(const PG8_LAS bf16x8*)(lds + PG8_SA(b, h) + aoff + m * 2048 + k * 1024); } while (0)
#define PG8_LDB(dst, b, h) do { _Pragma("unroll") for (int n = 0; n < 2; ++n) _Pragma("unroll") for (int k = 0; k < 2; ++k) dst[n][k] = *(const PG8_LAS bf16x8*)(lds + PG8_SB(b, h) + boff + n * 2048 + k * 1024); } while (0)
#define PG8_MMA(ai, bj, At, Bt) do { __builtin_amdgcn_s_setprio(1); _Pragma("unroll") for (int m = 0; m < 4; ++m) _Pragma("unroll") for (int n = 0; n < 2; ++n) _Pragma("unroll") for (int k = 0; k < 2; ++k) \
        acc[ai][bj][m][n] = __builtin_amdgcn_mfma_f32_16x16x32_bf16(Bt[n][k], At[m][k], acc[ai][bj][m][n], 0, 0, 0); __builtin_amdgcn_s_setprio(0); } while (0)
#define PG8_WAIT_V(n) asm volatile("s_waitcnt vmcnt(" #n ")" ::: "memory")
#define PG8_WAIT_L(n) asm volatile("s_waitcnt lgkmcnt(" #n ")" ::: "memory")
#define PG8_BAR __builtin_amdgcn_s_barrier()
#define PG8_SCHED __builtin_amdgcn_sched_barrier(0)
    Unit cur, nxt; int ui = 0;
    if (!S.next(0, cur)) return;
    f32x4 acc[2][2][4][2];
#pragma unroll
    for (int a = 0; a < 2; ++a)
#pragma unroll
        for (int b = 0; b < 2; ++b)
#pragma unroll
            for (int m = 0; m < 4; ++m)
#pragma unroll
                for (int n = 0; n < 2; ++n) acc[a][b][m][n] = (f32x4){0.f, 0.f, 0.f, 0.f};
    bf16x8 At[4][2], B0[2][2], B1[2][2];
    const char* cA = GATHER ? (const char*)g.A : (const char*)g.A + (size_t)cur.pm * tstep; const char* cB = (const char*)g.Bt + (size_t)cur.pn * tstep;
    if constexpr (GATHER) { PG8_GLOOK(gC, cur); }
    S.a_ready(cur);
    if constexpr (SP2) {
        PG8_STAGE(PG8_SB(0, 0), cB, voffB); PG8_STAGE(PG8_SB(0, 1), cB + hstep, voffB); PG8_STAGE_A(PG8_SA(0, 0), cA, 0, false); PG8_STAGE_A(PG8_SA(0, 1), cA, 1, false);
        if (wr == 1) PG8_BAR;
        PG8_WAIT_V(2); PG8_BAR;
        PG8_STAGE(PG8_SB(1, 0), cB + kstep, voffB); PG8_STAGE_A(PG8_SA(1, 0), cA + kstep, 0, false); PG8_STAGE(PG8_SB(1, 1), cB + hstep + kstep, voffB);
        PG8_WAIT_V(6); PG8_BAR;
    } else {
        PG8_STAGE(PG8_SB(0, 0), cB, voffB); PG8_STAGE(PG8_SA(0, 0), cA, voffA); PG8_STAGE(PG8_SB(0, 1), cB + hstep, voffB); PG8_STAGE(PG8_SA(0, 1), cA + hstep, voffA);
        if (wr == 1) PG8_BAR;
        PG8_WAIT_V(4); PG8_BAR;
        PG8_STAGE(PG8_SB(1, 0), cB + kstep, voffB); PG8_STAGE(PG8_SA(1, 0), cA + kstep, voffA); PG8_STAGE(PG8_SB(1, 1), cB + hstep + kstep, voffB);
        PG8_WAIT_V(6); PG8_BAR;
    }
    for (;;) {
        const bool has_next = S.next(ui + 1, nxt);
        const char* nA = (has_next && !GATHER) ? (const char*)g.A + (size_t)nxt.pm * tstep : cA; const char* nB = has_next ? (const char*)g.Bt + (size_t)nxt.pn * tstep : cB;
        if constexpr (GATHER) { if (has_next) { PG8_GLOOK(gN, nxt); } else {
#pragma unroll
            for (int _h = 0; _h < 2; ++_h)
#pragma unroll
                for (int _i = 0; _i < 2; ++_i) gN[_h][_i] = gC[_h][_i]; } }
        for (int t = 0; t < nt; t += 2) {
            const bool last = (t == nt - 2);
            const char* a1 = cA + (size_t)(t + 1) * kstep;
            const char* a2 = last ? nA : cA + (size_t)(t + 2) * kstep; const char* b2 = last ? nB : cB + (size_t)(t + 2) * kstep;
            const char* a3 = a2 + kstep; const char* b3 = b2 + kstep;
            if (last && has_next) S.a_ready(nxt);
            if constexpr (SP2) {
            PG8_LDB(B0, 0, 0); PG8_LDB(B1, 0, 1); PG8_SCHED; PG8_LDA(At, 0, 0); PG8_STAGE_A(PG8_SA(1, 1), a1, 1, false);
            PG8_WAIT_V(8); PG8_WAIT_L(0); PG8_BAR; PG8_MMA(0, 0, At, B0); PG8_MMA(0, 1, At, B1); PG8_BAR; PG8_SCHED;
            PG8_LDA(At, 0, 1); PG8_STAGE(PG8_SB(0, 0), b2, voffB); PG8_STAGE(PG8_SB(0, 1), b2 + hstep, voffB); PG8_STAGE_A(PG8_SA(0, 0), a2, 0, last);
            PG8_WAIT_V(8); PG8_WAIT_L(0); PG8_BAR; PG8_MMA(1, 0, At, B0); PG8_MMA(1, 1, At, B1); PG8_BAR; PG8_SCHED;
            PG8_LDB(B0, 1, 0); PG8_LDB(B1, 1, 1); PG8_SCHED; PG8_LDA(At, 1, 0); PG8_STAGE_A(PG8_SA(0, 1), a2, 1, last);
            PG8_WAIT_V(8); PG8_WAIT_L(0); PG8_BAR; PG8_MMA(0, 0, At, B0); PG8_MMA(0, 1, At, B1); PG8_BAR; PG8_SCHED;
            PG8_LDA(At, 1, 1); PG8_STAGE(PG8_SB(1, 0), b3, voffB); PG8_STAGE(PG8_SB(1, 1), b3 + hstep, voffB); PG8_STAGE_A(PG8_SA(1, 0), a3, 0, last);
            PG8_WAIT_V(8); PG8_WAIT_L(0); PG8_BAR; PG8_MMA(1, 0, At, B0); PG8_MMA(1, 1, At, B1); PG8_BAR; PG8_SCHED;
            } else {
            PG8_LDB(B0, 0, 0); PG8_SCHED; PG8_LDA(At, 0, 0); PG8_STAGE(PG8_SA(1, 1), a1 + hstep, voffA);
            PG8_WAIT_L(8); PG8_BAR; PG8_WAIT_L(0); PG8_MMA(0, 0, At, B0); PG8_BAR; PG8_SCHED;
            PG8_LDB(B1, 0, 1); PG8_STAGE(PG8_SB(0, 0), b2, voffB);
            PG8_BAR; PG8_WAIT_L(0); PG8_MMA(0, 1, At, B1); PG8_BAR;
            PG8_LDA(At, 0, 1); PG8_STAGE(PG8_SA(0, 0), a2, voffA);
            PG8_BAR; PG8_WAIT_L(0); PG8_MMA(1, 0, At, B0); PG8_BAR; PG8_SCHED;
            PG8_STAGE(PG8_SB(0, 1), b2 + hstep, voffB);
            PG8_WAIT_V(6); PG8_BAR; PG8_MMA(1, 1, At, B1); PG8_BAR;
            PG8_LDB(B0, 1, 0); PG8_SCHED; PG8_LDA(At, 1, 0); PG8_STAGE(PG8_SA(0, 1), a2 + hstep, voffA);
            PG8_WAIT_L(8); PG8_BAR; PG8_WAIT_L(0); PG8_MMA(0, 0, At, B0); PG8_BAR; PG8_SCHED;
            PG8_LDB(B1, 1, 1); PG8_STAGE(PG8_SB(1, 0), b3, voffB);
            PG8_BAR; PG8_WAIT_L(0); PG8_MMA(0, 1, At, B1); PG8_BAR;
            PG8_LDA(At, 1, 1); PG8_STAGE(PG8_SA(1, 0), a3, voffA);
            PG8_BAR; PG8_WAIT_L(0); PG8_MMA(1, 0, At, B0); PG8_BAR; PG8_SCHED;
            PG8_STAGE(PG8_SB(1, 1), b3 + hstep, voffB);
            PG8_WAIT_V(6); PG8_BAR; PG8_MMA(1, 1, At, B1); PG8_BAR;
            }
        }
        if constexpr (ALIGN_EPI) { if (wr == 0) PG8_BAR; }
        if constexpr (!Epi::AFTER_DRAIN) { E(acc, cur, wr, wc, fr, fq); S.done(cur); }
        if (!has_next) break;
#pragma unroll
        for (int a = 0; a < 2; ++a)
#pragma unroll
            for (int b = 0; b < 2; ++b)
#pragma unroll
                for (int m = 0; m < 4; ++m)
#pragma unroll
                    for (int n = 0; n < 2; ++n) acc[a][b][m][n] = (f32x4){0.f, 0.f, 0.f, 0.f};
        cur = nxt; cA = nA; cB = nB; ++ui;
        if constexpr (GATHER) {
#pragma unroll
            for (int _h = 0; _h < 2; ++_h)
#pragma unroll
                for (int _i = 0; _i < 2; ++_i) gC[_h][_i] = gN[_h][_i]; }
        if constexpr (ALIGN_EPI) { if (wr == 1) PG8_BAR; }
    }
    PG8_WAIT_V(0);
    if constexpr (!ALIGN_EPI) { if (wr == 0) PG8_BAR; }
    PG8_BAR;
    if constexpr (Epi::AFTER_DRAIN) { E.fused(acc, cur, wr, wc, fr, fq, lds, wid, lane); S.done(cur); }
#undef PG8_SA
#undef PG8_SB
#undef PG8_STAGE
#undef PG8_STAGE_A
#undef PG8_GLOOK
#undef PG8_LDA
#undef PG8_LDB
#undef PG8_MMA
#undef PG8_WAIT_V
#undef PG8_WAIT_L
#undef PG8_BAR
#undef PG8_SCHED
}
}

#define XB_TMO      128
#define XB_XCNT(j)  (256  + 64 * (j))
#define XB_XSUB(j)  (1280 + 64 * (j))
#define XB_XGEN(j)  (2304 + 64 * (j))
#define XB_TOP      3328
#define XB_TOPGEN   3392
#define XCD_BAR_WORDS 3456
#define XB_SPIN_CAP (1u << 18)

__device__ __forceinline__ unsigned xb_ld(unsigned* p)              { return __hip_atomic_load(p, __ATOMIC_RELAXED, __HIP_MEMORY_SCOPE_AGENT); }
__device__ __forceinline__ unsigned xb_add(unsigned* p, unsigned v) { return __hip_atomic_fetch_add(p, v, __ATOMIC_RELAXED, __HIP_MEMORY_SCOPE_AGENT); }
__device__ __forceinline__ unsigned xb_xcc_id() { return (unsigned)__builtin_amdgcn_s_getreg((3 << 11) | 20) & 0xFu; }
#define XB_SPIN(cond, bar) do { unsigned _sp = 0; while (cond) { __builtin_amdgcn_s_sleep(1); \
    if ((++_sp & 255u) == 0u) { if (xb_ld(&(bar)[XB_TMO])) break; if (_sp > XB_SPIN_CAP) { atomicAdd(&(bar)[XB_TMO], 1u); break; } } } } while (0)

struct XcdBarrier {
    unsigned* bar; unsigned x;
    volatile LAS unsigned* st;
};

__device__ __forceinline__ XcdBarrier xcd_barrier_post(unsigned* bar, volatile LAS unsigned* st) {
    XcdBarrier b; b.bar = bar; b.x = xb_xcc_id(); b.st = st;
    if (threadIdx.x == 0) (void)xb_add(&bar[XB_XCNT(b.x)], 1u);
    return b;
}
__device__ __forceinline__ void xcd_barrier_complete(unsigned* bar, unsigned x, unsigned& nloc, unsigned& nx) {
    const unsigned G = gridDim.x * gridDim.y * gridDim.z;
    unsigned sum, cnt, mine, sp = 0u;
    for (;;) {
        sum = 0u; cnt = 0u; mine = 0u;
#pragma unroll
        for (unsigned j = 0; j < 16; ++j) { const unsigned c = xb_ld(&bar[XB_XCNT(j)]); sum += c; cnt += (c > 0u) ? 1u : 0u; mine = (j == x) ? c : mine; }
        if (sum == G) break;
        __builtin_amdgcn_s_sleep(1);
        if ((++sp & 255u) == 0u) { if (xb_ld(&bar[XB_TMO])) break; if (sp > XB_SPIN_CAP) { atomicAdd(&bar[XB_TMO], 1u); break; } }
    }
    nloc = mine > 0u ? mine : 1u; nx = cnt > 0u ? cnt : 1u;
}

__device__ __forceinline__ void xcd_barrier(const XcdBarrier& b) {
    asm volatile("s_waitcnt vmcnt(0)" ::: "memory");
    __syncthreads();
    if (threadIdx.x == 0) {
        unsigned* bar = b.bar;
        __builtin_amdgcn_s_waitcnt(0);
        unsigned nloc = b.st[0], nx = b.st[1];
        if (nloc == 0u) { xcd_barrier_complete(bar, b.x, nloc, nx); b.st[0] = nloc; b.st[1] = nx; }
        const unsigned old = xb_add(&bar[XB_XSUB(b.x)], 1u);
        const unsigned gen = old / nloc;
        if (old + 1u == (gen + 1u) * nloc) {
            __builtin_amdgcn_fence(__ATOMIC_RELEASE, "agent");
            asm volatile("s_waitcnt vmcnt(0)" ::: "memory");
            const unsigned og = xb_add(&bar[XB_TOP], 1u);
            const unsigned tg = og / nx;
            if (og + 1u == (tg + 1u) * nx) xb_add(&bar[XB_TOPGEN], 1u);
            else XB_SPIN(xb_ld(&bar[XB_TOPGEN]) == tg, bar);
            __builtin_amdgcn_fence(__ATOMIC_ACQUIRE, "agent");
            xb_add(&bar[XB_XGEN(b.x)], 1u);
            asm volatile("s_waitcnt vmcnt(0)" ::: "memory");
        } else {
            XB_SPIN(xb_ld(&bar[XB_XGEN(b.x)]) == gen, bar);
            __builtin_amdgcn_fence(__ATOMIC_ACQUIRE, "agent");
            asm volatile("s_waitcnt vmcnt(0)" ::: "memory");
        }
    }
    __syncthreads();
}

constexpr int NWAVES = 8;
constexpr int RING_BYTES = 131072, LDSCTL_OFF = RING_BYTES, MISC_OFF = LDSCTL_OFF + 320, TILEE_OFF = LDSCTL_OFF + 1024, PS_OFF = LDSCTL_OFF + 2048;
constexpr int LDS_BYTES = 147456;
constexpr int NPHASE = 9;

struct Frame {
    LAS unsigned char* lds; volatile LAS unsigned* MISC; unsigned* ctl;
    int tid, lane, wave, vcu, G;
};

__device__ __forceinline__ void moe_tables(Frame& F) {
    LAS int* ps = (LAS int*)(F.lds + PS_OFF); LAS int* te = (LAS int*)(F.lds + TILEE_OFF);
    if (F.wave == 0) {
        const int e = F.lane & 31;
        const int nt = (int)((__hip_atomic_load(F.ctl + CW_CNT + 64 * e, __ATOMIC_RELAXED, __HIP_MEMORY_SCOPE_AGENT) + 255u) >> 8);
        int inc = nt;
#pragma unroll
        for (int o = 1; o < 32; o <<= 1) { const int v = __shfl_up(inc, o, 32); if (e >= o) inc += v; }
        if (F.lane < 32) { ps[e] = inc - nt; if (e == 31) ps[32] = inc; for (int t = inc - nt; t < inc; ++t) te[t] = e; }
    }
    __syncthreads();
}

__device__ __forceinline__ void convert_experts(Frame& F, const Ptrs& p, int part, int nparts) {
    float* scr = (float*)(F.lds + F.wave * 8704);
    const int lane = F.lane;
    bf16* Wgu = (bf16*)(p.ws + WS_WGU); bf16* Wd = (bf16*)(p.ws + WS_WD);
    constexpr int I_G = (D / 64) * (DEXP / 32), I_DN = (DEXP / 64) * (D / 32);
    constexpr int NITEMS = NEXP * (2 * I_G + I_DN);
    for (int it = part * NWAVES + F.wave; it < NITEMS; it += nparts * NWAVES) {
        int r = it;
        const int e = r / (2 * I_G + I_DN); r -= e * (2 * I_G + I_DN);
        if (r < 2 * I_G) { const int up = r / I_G; r -= up * I_G; const int nblk = DEXP / 32, kb = r / nblk, nb = r % nblk; const int c0 = 32 * nb;
            transpose_item((up ? p.w_up : p.w_gate) + (size_t)e * D * DEXP, D, DEXP, Wgu + (size_t)e * 1024 * D, 64 * kb, c0, 256 * (c0 >> 7) + 128 * up + (c0 & 127), scr, lane); continue; }
        r -= 2 * I_G;
        { const int nblk = D / 32, kb = r / nblk, nb = r % nblk; transpose_item(p.w_down + (size_t)e * DEXP * D, DEXP, D, Wd + (size_t)e * D * DEXP, 64 * kb, 32 * nb, 32 * nb, scr, lane); }
    }
}
__device__ __forceinline__ void p0_prologue(Frame& F, const Ptrs& p) {
    float* scr = (float*)(F.lds + F.wave * 8704);
    const int lane = F.lane;
    const int gw = F.vcu * NWAVES + F.wave, NGW = F.G * NWAVES;
    bf16* Wt_in = (bf16*)(p.ws + WS_WIN); bf16* Wt_out = (bf16*)(p.ws + WS_WOUT);
    constexpr int I_IN = (D / 64) * (DIN / 32), I_OUT = (D / 64) * (D / 32);
    constexpr int NITEMS = I_IN + I_OUT;
    for (int it = gw; it < NITEMS; it += NGW) {
        int r = it;
        if (r < I_IN) { const int nblk = DIN / 32, kb = r / nblk, nb = r % nblk; transpose_item(p.w_in, D, DIN, Wt_in, 64 * kb, 32 * nb, win_row_of_col(32 * nb), scr, lane); continue; } r -= I_IN;
        { const int nblk = D / 32, kb = r / nblk, nb = r % nblk; transpose_item(p.w_out, D, D, Wt_out, 64 * kb, 32 * nb, 32 * nb, scr, lane); }
    }
    bf16* A = (bf16*)(p.ws + WS_R2);
    for (int m = gw; m < MROWS; m += NGW) {
        u32x2* o8 = (u32x2*)(A + (size_t)m * D) + lane;
        if (m >= NTOK + NMETA) {
#pragma unroll
            for (int j = 0; j < 4; ++j) o8[64 * j] = (u32x2){0u, 0u};
            continue; }
        const float* xrow = (m < NTOK) ? p.x + (size_t)m * D : p.meta + (size_t)(m - NTOK) * D;
        const f32x4* xr = (const f32x4*)xrow + lane;
        f32x4 v[4]; float s = 0.f;
#pragma unroll
        for (int j = 0; j < 4; ++j) { v[j] = xr[64 * j]; s += (v[j].x * v[j].x + v[j].y * v[j].y) + (v[j].z * v[j].z + v[j].w * v[j].w); }
        const float rstd = 1.f / sqrtf(wave_sum(s) * (1.f / D) + EPS);
#pragma unroll
        for (int j = 0; j < 4; ++j) { const f32x4 g = ((const f32x4*)p.g1)[lane + 64 * j];
            o8[64 * j] = (u32x2){pk2(v[j].x * rstd * g.x, v[j].y * rstd * g.y), pk2(v[j].z * rstd * g.z, v[j].w * rstd * g.w)}; }
    }
    if (blockIdx.x == 0) {
        float* sm = (float*)(p.ws + WS_SM);
        for (int i = F.tid; i < 12 * 128; i += NWAVES * 64) { const int hd = i >> 7, dist = i & 127; sm[i] = p.rel_bias[t5_bucket(dist) * 12 + hd] * LOG2E; }
        if (F.tid < 64) { const int l = F.tid; const float a = wave_sum(p.lq1[l] * p.lk1[l]), b = wave_sum(p.lq2[l] * p.lk2[l]); if (l == 0) sm[SM_LAM] = expf(a) - expf(b) + 0.2f; }
    }
}

__device__ __forceinline__ void p4_router(Frame& F, const Ptrs& p) {
    const int lane = F.lane, w = F.wave, r = lane & 15, kq = lane >> 4;
    LAS float* part = (LAS float*)(F.lds);
    LAS float* pss = (LAS float*)(F.lds + 24576);
    LAS float* logit = (LAS float*)(F.lds + 25600);
    LAS float* rstd_s = (LAS float*)(F.lds + 38400);
    LAS unsigned* lcnt = (LAS unsigned*)(F.lds + 38912);
    const int k0 = 128 * w + 32 * kq;
    float bw[3][32], g2v[32];
#pragma unroll
    for (int j = 0; j < 32; ++j) { const int k = k0 + j; const float g = p.g2[k]; g2v[j] = g;
        bw[0][j] = g * (r < 4 ? p.w_group[k * 4 + r] : p.w_router[k * 32 + r - 4]);
        bw[1][j] = g * p.w_router[k * 32 + 12 + r];
        bw[2][j] = (r < 4) ? g * p.w_router[k * 32 + 28 + (r & 3)] : 0.f; }
    bf16* T = (bf16*)(p.ws + WS_R1);
    unsigned* ctl = F.ctl;
    for (int grp = F.vcu; grp < NTOK / 64; grp += F.G) {
        const int tok0 = grp * 64;
        if (F.tid < 64) lcnt[F.tid] = 0u;
        for (int ps_ = 0; ps_ < 4; ++ps_) {
            const int row = tok0 + 16 * ps_ + r;
            const f32x4* hp = (const f32x4*)(p.out + (size_t)row * D + k0);
            f32x4 a4[8];
#pragma unroll
            for (int j = 0; j < 8; ++j) a4[j] = hp[j];
            float ss = 0.f; f32x4 acc[3] = {(f32x4){0.f, 0.f, 0.f, 0.f}, (f32x4){0.f, 0.f, 0.f, 0.f}, (f32x4){0.f, 0.f, 0.f, 0.f}};
#pragma unroll
            for (int j = 0; j < 32; ++j) { const float av = a4[j >> 2][j & 3]; ss += av * av;
#pragma unroll
                for (int nb = 0; nb < 3; ++nb) acc[nb] = __builtin_amdgcn_mfma_f32_16x16x4f32(av, bw[nb][j], acc[nb], 0, 0, 0); }
            ss += __shfl_xor(ss, 16); ss += __shfl_xor(ss, 32);
            if (ps_ > 0) __syncthreads();
            if (kq == 0) pss[w * 16 + r] = ss;
#pragma unroll
            for (int nb = 0; nb < 3; ++nb)
#pragma unroll
                for (int i = 0; i < 4; ++i) part[(w * 16 + kq * 4 + i) * 48 + nb * 16 + r] = acc[nb][i];
            __syncthreads();
            if (F.tid < 16) { float s2 = 0.f;
#pragma unroll
                for (int ww = 0; ww < 8; ++ww) s2 += pss[ww * 16 + F.tid];
                rstd_s[F.tid] = 1.f / sqrtf(s2 * (1.f / D) + EPS); }
            __syncthreads();
            for (int idx = F.tid; idx < 16 * 36; idx += NWAVES * 64) { const int rr = idx / 36, c = idx - rr * 36; float v = 0.f;
#pragma unroll
                for (int ww = 0; ww < 8; ++ww) v += part[(ww * 16 + rr) * 48 + c];
                logit[(16 * ps_ + rr) * 49 + c] = v * rstd_s[rr] + (c < 4 ? p.b_group[c] : p.b_router[c - 4]); }
            { const float rs = rstd_s[r]; u32x4 o4[4];
#pragma unroll
              for (int q = 0; q < 4; ++q) { const f32x4 x0 = a4[2 * q], x1 = a4[2 * q + 1];
                  o4[q] = (u32x4){pk2(x0[0] * rs * g2v[8 * q], x0[1] * rs * g2v[8 * q + 1]), pk2(x0[2] * rs * g2v[8 * q + 2], x0[3] * rs * g2v[8 * q + 3]),
                                  pk2(x1[0] * rs * g2v[8 * q + 4], x1[1] * rs * g2v[8 * q + 5]), pk2(x1[2] * rs * g2v[8 * q + 6], x1[3] * rs * g2v[8 * q + 7])}; }
              u32x4* tp = (u32x4*)(T + (size_t)row * D + k0);
#pragma unroll
              for (int q = 0; q < 4; ++q) tp[q] = o4[q]; }
        }
        __syncthreads();
        if (w == 0) {
            const LAS float* lg = logit + lane * 49;
            float gl[4];
#pragma unroll
            for (int c = 0; c < 4; ++c) gl[c] = lg[c];
            int g = 0; float gm = gl[0];
#pragma unroll
            for (int c = 1; c < 4; ++c) if (gl[c] > gm) { gm = gl[c]; g = c; }
            float den = 0.f;
#pragma unroll
            for (int c = 0; c < 4; ++c) den += expf(gl[c] - gm);
            const float g_w = 1.f / den;
            float el[8];
#pragma unroll
            for (int c = 0; c < 8; ++c) el[c] = lg[4 + 8 * g + c];
            int j0 = 0; float l0 = el[0];
#pragma unroll
            for (int c = 1; c < 8; ++c) if (el[c] > l0) { l0 = el[c]; j0 = c; }
            int j1 = -1; float l1 = -3.0e38f;
#pragma unroll
            for (int c = 0; c < 8; ++c) if (c != j0 && el[c] > l1) { l1 = el[c]; j1 = c; }
            const float e1 = expf(l1 - l0), ga = g_w / (1.f + e1), gb = g_w * e1 / (1.f + e1);
            const int ea = g * 8 + j0, eb = g * 8 + j1, tok = tok0 + lane;
            const unsigned ra = __hip_atomic_fetch_add(lcnt + ea, 1u, __ATOMIC_RELAXED, __HIP_MEMORY_SCOPE_WORKGROUP), rb = __hip_atomic_fetch_add(lcnt + eb, 1u, __ATOMIC_RELAXED, __HIP_MEMORY_SCOPE_WORKGROUP);
            asm volatile("s_waitcnt vmcnt(0) lgkmcnt(0)" ::: "memory");
            if (lane < 32) { const unsigned n = lcnt[lane]; lcnt[32 + lane] = n ? atomicAdd(&ctl[CW_CNT + 64 * lane], n) : 0u; }
            asm volatile("s_waitcnt vmcnt(0) lgkmcnt(0)" ::: "memory");
            const unsigned pa = lcnt[32 + ea] + ra, pb = lcnt[32 + eb] + rb;
            unsigned* ep = (unsigned*)(p.ws + WS_TOK + TOK_EP); unsigned* ltok = (unsigned*)(p.ws + WS_LIST); float* lgate = (float*)(p.ws + WS_LIST + (size_t)NEXP * LISTCAP * 4);
            ep[2 * tok] = ((unsigned)ea << 20) | pa; ep[2 * tok + 1] = ((unsigned)eb << 20) | pb;
            ltok[(size_t)ea * LISTCAP + pa] = (unsigned)tok; ltok[(size_t)eb * LISTCAP + pb] = (unsigned)tok;
            lgate[(size_t)ea * LISTCAP + pa] = ga; lgate[(size_t)eb * LISTCAP + pb] = gb;
        }
        __syncthreads();
    }
}

__device__ __forceinline__ void p8_combine(Frame& F, const Ptrs& p) {
    const LAS int* ps = (const LAS int*)(F.lds + PS_OFF);
    const int lane = F.lane, gw = F.vcu * NWAVES + F.wave, NGW = F.G * NWAVES;
    const unsigned* ep = (const unsigned*)(p.ws + WS_TOK + TOK_EP); const bf16* Y = (const bf16*)(p.ws + WS_R1);
    for (int tok = gw; tok < NTOK; tok += NGW) {
        const unsigned r0 = ep[2 * tok], r1 = ep[2 * tok + 1];
        const int s0 = ps[r0 >> 20] * 256 + (int)(r0 & 0xfffffu), s1 = ps[r1 >> 20] * 256 + (int)(r1 & 0xfffffu);
        f32x4* hr = (f32x4*)(p.out + (size_t)tok * D) + lane;
        const u32x2* y0 = (const u32x2*)(Y + (size_t)s0 * D) + lane; const u32x2* y1 = (const u32x2*)(Y + (size_t)s1 * D) + lane;
#pragma unroll
        for (int j = 0; j < 4; ++j) { f32x4 v = hr[64 * j]; const u32x2 a = y0[64 * j], b = y1[64 * j];
            v.x += bf2f(a.x & 0xffff) + bf2f(b.x & 0xffff); v.y += bf2f(a.x >> 16) + bf2f(b.x >> 16); v.z += bf2f(a.y & 0xffff) + bf2f(b.y & 0xffff); v.w += bf2f(a.y >> 16) + bf2f(b.y >> 16);
            hr[64 * j] = v; }
    }
}


namespace att {
typedef short bf16x8 __attribute__((ext_vector_type(8)));
typedef short s16x4 __attribute__((ext_vector_type(4)));
typedef float f32x16 __attribute__((ext_vector_type(16)));
constexpr int SLOTB = 32768, K1_OFF = 8192, V_OFF = 16384;
constexpr int WSF_OFF = LDSCTL_OFF + 12288;
constexpr int NSLOT = 4;
constexpr int STG_BYTES = 17408;
constexpr int BT_OFF = LDSCTL_OFF + 4096;
constexpr float THR = 8.f;
__device__ __forceinline__ int crow(int r, int hi) { return (r & 3) + 8 * (r >> 2) + 4 * hi; }
__device__ __forceinline__ float max3f(float a, float b, float c) { return __builtin_fmaxf(__builtin_fmaxf(a, b), c); }
__device__ __forceinline__ float max2f(float a, float b) { return __builtin_fmaxf(a, b); }
__device__ __forceinline__ void glds16(const void* gsrc, unsigned lds_dst) { unsigned keep;
    asm volatile("s_mov_b32 %0, m0\n\ts_mov_b32 m0, %2\n\ts_nop 0\n\tglobal_load_lds_dwordx4 %1, off\n\ts_mov_b32 m0, %0" : "=&s"(keep) : "v"(gsrc), "s"(lds_dst) : "memory"); }
__device__ __forceinline__ s16x4 vtr(const LAS unsigned char* p) { typedef short v4i16_t __attribute__((ext_vector_type(4))); return __builtin_bit_cast(s16x4, __builtin_amdgcn_ds_read_tr16_b64_v4i16((LAS v4i16_t*)p)); }
__device__ __forceinline__ unsigned cvtpk(float lo, float hi) { typedef float f2 __attribute__((ext_vector_type(2))); typedef __bf16 b2 __attribute__((ext_vector_type(2))); f2 v = {lo, hi}; b2 b = __builtin_convertvector(v, b2); return __builtin_bit_cast(unsigned, b); }

template <bool DIFF>
__device__ __forceinline__ void attn_unit(Frame& F, const Ptrs& p, int b, int hh, int q0) {
    constexpr int NDH = DIFF ? 4 : 2;
    const bf16* P = (const bf16*)(p.ws + WS_R1); bf16* mix = (bf16*)(p.ws + WS_R2);
    LAS unsigned char* lds = F.lds;
    int lane = F.lane; asm volatile("" : "+v"(lane));
    const int r32 = lane & 31, hi = lane >> 5, w = F.wave;
    const int m = DIFF ? (w >> 2) : 0;
    const int r0 = DIFF ? q0 + 32 * (w & 3) : q0 + 32 * (w & 1);
    const int hq = DIFF ? hh : hh * 4 + (w >> 1);
    const int qcol = DIFF ? C_DQ + hh * 128 + m * 64 : C_SQ + hq * 64;
    const int kcol = DIFF ? C_DK + hh * 128 : C_SK + hh * 64;
    const int vcol = DIFF ? C_DV + hh * 128 : C_SV + hh * 64;
    const LAS float* btab = (const LAS float*)(lds + BT_OFF) + (DIFF ? hh : 4 + hq) * 128;
    LAS float* wsf = (LAS float*)(lds + WSF_OFF) + w * 64;
    const int tq = r0 + r32;
    const int tt_first = DIFF ? 0 : ((q0 >> 6) >= 2 ? (q0 >> 6) - 2 : 0), tt_last = DIFF ? (q0 >> 6) + 1 : (q0 >> 6);
    const int NT = 2 + tt_last - tt_first;
    const int koff = (DIFF && m) ? K1_OFF : 0;
    const int kfo = koff + hi * 1024 + r32 * 16;
    const int vfo = V_OFF + ((lane >> 4) & 1) * 32 + (lane & 3) * 8 + (4 * hi + ((lane & 15) >> 2)) * 64;
    const unsigned lds0 = (unsigned)(size_t)lds;
    const unsigned dkl = (unsigned)lane * (unsigned)(DIN * 2), dvl = (unsigned)(lane >> 2) * (unsigned)(DIN * 2) + (unsigned)(lane & 3) * 16u;
#define ATT_DMA(i, s) do { const int i_ = (i); const size_t rowbase = (i_ == 0) ? (size_t)NTOK : (size_t)b * SEQ + 64 * (tt_first + i_ - 1); \
        const unsigned sl_ = lds0 + (unsigned)(s) * SLOTB; const char* gb_ = (const char*)P + rowbase * (size_t)(DIN * 2); \
        glds16(gb_ + (kcol + w * 8) * 2 + dkl, (unsigned)__builtin_amdgcn_readfirstlane(sl_ + w * 1024)); \
        if (DIFF) glds16(gb_ + (kcol + 64 + w * 8) * 2 + dkl, (unsigned)__builtin_amdgcn_readfirstlane(sl_ + K1_OFF + w * 1024)); \
        _Pragma("unroll") for (int j_ = 0; j_ < (DIFF ? 2 : 1); ++j_) { const int id_ = w + 8 * j_, dh_ = id_ >> 2, kg_ = id_ & 3; \
            glds16(gb_ + (size_t)(16 * kg_) * (DIN * 2) + (vcol + dh_ * 32) * 2 + dvl, (unsigned)__builtin_amdgcn_readfirstlane(sl_ + V_OFF + id_ * 1024)); } } while (0)
#define ATT_SBAR() __builtin_amdgcn_sched_barrier(0)
    ATT_DMA(0, 0);
    if (NT > 1) ATT_DMA(1, 1);
    if (NT > 2) ATT_DMA(2, 2);
    bf16x8 qr[4];
    { const bf16* qp = P + ((size_t)b * SEQ + tq) * DIN + qcol + hi * 8;
#pragma unroll
      for (int d0 = 0; d0 < 4; ++d0) qr[d0] = *(const bf16x8*)(qp + d0 * 16); }
    float mref = 0.f, l_reg = 0.f;
    f32x16 o[NDH];
#pragma unroll
    for (int dh = 0; dh < NDH; ++dh) o[dh] = f32x16{};
    f32x16 sA, sB;
    u32x4 pw[2];
#define ATT_BIAS4(X, i, hf, c, MA) do { const int i_ = (i); const int tok0_ = 64 * (tt_first + i_ - 1) + 32 * (hf); const bool meta_ = (i_ == 0); \
        const bool near_ = meta_ || (DIFF ? (tok0_ + 31 >= r0 - 127) : true); \
        if (near_) { const int delta_ = meta_ ? 16 + tq - 32 * (hf) : tq - tok0_; \
            _Pragma("unroll") for (int r_ = 4 * (c); r_ < 4 * (c) + 4; ++r_) { const int kk_ = crow(r_, hi); const int d0_ = delta_ - kk_; \
                const float b0_ = btab[min(max(d0_, 0), 127)]; bool ok0_; \
                if (meta_) { ok0_ = (hf) == 0 && kk_ < 16; } else if (DIFF) { ok0_ = d0_ >= 0; } else { ok0_ = d0_ >= 0 && d0_ < 128; } \
                X[r_] = ok0_ ? X[r_] + b0_ : -INFINITY; } } \
        MA = max3f(MA, X[4 * (c)], X[4 * (c) + 1]); MA = max3f(MA, X[4 * (c) + 2], X[4 * (c) + 3]); } while (0)
#define ATT_ROWMAX(MA, RM) do { float rm_ = (MA); auto rr_ = __builtin_amdgcn_permlane32_swap(__float_as_uint(rm_), __float_as_uint(rm_), false, false); RM = max2f(__uint_as_float(rr_[0]), __uint_as_float(rr_[1])); } while (0)
#define ATT_KF(kb, hf, d0) (*(const LAS bf16x8*)((kb) + (d0) * 2048 + (hf) * 512))
#define ATT_VREAD(dst, vb, ks) do { _Pragma("unroll") for (int dh_ = 0; dh_ < NDH; ++dh_) { dst[2 * dh_] = vtr((vb) + dh_ * 4096 + (ks) * 1024); dst[2 * dh_ + 1] = vtr((vb) + dh_ * 4096 + (ks) * 1024 + 512); } } while (0)
#define ATT_PV4(src, pwv) do { _Pragma("unroll") for (int dh_ = 0; dh_ < NDH; ++dh_) { const s16x4 lo_ = src[2 * dh_], hi_ = src[2 * dh_ + 1]; \
        const bf16x8 vf_ = (bf16x8){lo_[0], lo_[1], lo_[2], lo_[3], hi_[0], hi_[1], hi_[2], hi_[3]}; \
        o[dh_] = __builtin_amdgcn_mfma_f32_32x32x16_bf16(__builtin_bit_cast(bf16x8, pwv), vf_, o[dh_], 0, 0, 0); } } while (0)
#define ATT_EXP4(C, base, PW, wi) do { const float e0_ = __builtin_amdgcn_exp2f(C[base] - mref), e1_ = __builtin_amdgcn_exp2f(C[base + 1] - mref), e2_ = __builtin_amdgcn_exp2f(C[base + 2] - mref), e3_ = __builtin_amdgcn_exp2f(C[base + 3] - mref); \
        sacc += (e0_ + e1_) + (e2_ + e3_); PW[wi] = cvtpk(e0_, e1_); PW[wi + 1] = cvtpk(e2_, e3_); } while (0)
    asm volatile("s_waitcnt vmcnt(0)" ::: "memory"); __builtin_amdgcn_s_barrier(); ATT_SBAR();
    if (NT > 3) ATT_DMA(3, 3);
    bf16x8 kq0, kq1, kq2, kq3;
    { const LAS unsigned char* kb_ = lds + kfo; asm volatile("" : "+v"(kb_));
      const bf16x8 k0_ = ATT_KF(kb_, 0, 0), k1_ = ATT_KF(kb_, 0, 1), k2_ = ATT_KF(kb_, 0, 2), k3_ = ATT_KF(kb_, 0, 3);
      kq0 = ATT_KF(kb_, 1, 0); kq1 = ATT_KF(kb_, 1, 1); kq2 = ATT_KF(kb_, 1, 2); kq3 = ATT_KF(kb_, 1, 3);
      sA = __builtin_amdgcn_mfma_f32_32x32x16_bf16(k0_, qr[0], f32x16{}, 0, 0, 0); sA = __builtin_amdgcn_mfma_f32_32x32x16_bf16(k1_, qr[1], sA, 0, 0, 0);
      sA = __builtin_amdgcn_mfma_f32_32x32x16_bf16(k2_, qr[2], sA, 0, 0, 0); sA = __builtin_amdgcn_mfma_f32_32x32x16_bf16(k3_, qr[3], sA, 0, 0, 0); }
    { float ma_ = -INFINITY; ATT_BIAS4(sA, 0, 0, 0, ma_); ATT_BIAS4(sA, 0, 0, 1, ma_); ATT_BIAS4(sA, 0, 0, 2, ma_); ATT_BIAS4(sA, 0, 0, 3, ma_); ATT_ROWMAX(ma_, mref); }
#define ATT_HSTEP(C, N, t, HF, TN, HN, SNN, HNN, VALID) do { \
        float sacc = 0.f; s16x4 va_[2 * NDH], vc_[2 * NDH]; \
        const LAS unsigned char* vb_ = lds + ((t) % NSLOT) * SLOTB + vfo; asm volatile("" : "+v"(vb_)); vb_ += (HF) * 2048; \
        ATT_VREAD(va_, vb_, 0); ATT_SBAR(); \
        N = __builtin_amdgcn_mfma_f32_32x32x16_bf16(kq0, qr[0], f32x16{}, 0, 0, 0); ATT_EXP4(C, 0, pw[0], 0); ATT_SBAR(); \
        N = __builtin_amdgcn_mfma_f32_32x32x16_bf16(kq1, qr[1], N, 0, 0, 0); ATT_EXP4(C, 4, pw[0], 2); ATT_SBAR(); \
        N = __builtin_amdgcn_mfma_f32_32x32x16_bf16(kq2, qr[2], N, 0, 0, 0); ATT_EXP4(C, 8, pw[1], 0); ATT_SBAR(); \
        N = __builtin_amdgcn_mfma_f32_32x32x16_bf16(kq3, qr[3], N, 0, 0, 0); ATT_EXP4(C, 12, pw[1], 2); ATT_SBAR(); \
        l_reg += sacc; \
        { float ma_ = -INFINITY; \
          ATT_VREAD(vc_, vb_, 1); \
          { const LAS unsigned char* kb_ = lds + (SNN) * SLOTB + kfo; asm volatile("" : "+v"(kb_)); kq0 = ATT_KF(kb_, HNN, 0); kq1 = ATT_KF(kb_, HNN, 1); kq2 = ATT_KF(kb_, HNN, 2); kq3 = ATT_KF(kb_, HNN, 3); } \
          ATT_SBAR(); \
          ATT_PV4(va_, pw[0]); ATT_BIAS4(N, TN, HN, 0, ma_); ATT_BIAS4(N, TN, HN, 1, ma_); ATT_SBAR(); \
          ATT_PV4(vc_, pw[1]); ATT_BIAS4(N, TN, HN, 2, ma_); ATT_BIAS4(N, TN, HN, 3, ma_); ATT_SBAR(); \
          float rm_n; ATT_ROWMAX(ma_, rm_n); \
          if ((VALID) && __any(rm_n - mref > THR)) { const float dl_ = fmaxf(rm_n - mref, 0.f); mref += dl_; const float f_ = __builtin_amdgcn_exp2f(-dl_); l_reg *= f_; \
              if (hi == 0) wsf[r32] = f_; \
              asm volatile("s_waitcnt lgkmcnt(0)" ::: "memory"); \
              _Pragma("unroll") for (int g_ = 0; g_ < 4; ++g_) { const f32x4 fv_ = *(const LAS f32x4*)(wsf + 8 * g_ + 4 * hi); \
                  _Pragma("unroll") for (int dh_ = 0; dh_ < NDH; ++dh_) _Pragma("unroll") for (int j_ = 0; j_ < 4; ++j_) o[dh_][4 * g_ + j_] *= fv_[j_]; } } } \
    } while (0)
    for (int t = 0; t < NT; ++t) {
        if (t > 0) { if (t + 2 < NT) { if (DIFF) asm volatile("s_waitcnt vmcnt(4)" ::: "memory"); else asm volatile("s_waitcnt vmcnt(2)" ::: "memory"); } else asm volatile("s_waitcnt vmcnt(0)" ::: "memory");
                     __builtin_amdgcn_s_barrier(); ATT_SBAR(); if (t + 3 < NT) ATT_DMA(t + 3, (t + 3) % NSLOT); }
        ATT_HSTEP(sA, sB, t, 0, t, 1, (t + 1) % NSLOT, 0, true);
        ATT_HSTEP(sB, sA, t, 1, t + 1, 0, (t + 1) % NSLOT, 1, t + 1 < NT);
    }
#undef ATT_HSTEP
#undef ATT_EXP4
#undef ATT_KF
#undef ATT_VREAD
#undef ATT_PV4
#undef ATT_BIAS4
#undef ATT_ROWMAX
#undef ATT_DMA
#undef ATT_SBAR
    { auto rr = __builtin_amdgcn_permlane32_swap(__float_as_uint(l_reg), __float_as_uint(l_reg), false, false); l_reg = __uint_as_float(rr[0]) + __uint_as_float(rr[1]); }
    if (!DIFF) l_reg += __builtin_amdgcn_exp2f(*((const LAS float*)(lds + BT_OFF) + 12 * 128 + hq) - mref);
    const float lam = *((const LAS float*)(lds + BT_OFF) + 12 * 128 + 8);
    if (hi == 0) wsf[r32] = ((DIFF && m) ? lam : 1.f) / l_reg;
    asm volatile("s_waitcnt lgkmcnt(0)" ::: "memory");
    float sc[16];
#pragma unroll
    for (int g = 0; g < 4; ++g) { const f32x4 fv = *(const LAS f32x4*)(wsf + 8 * g + 4 * hi); sc[4 * g] = fv[0]; sc[4 * g + 1] = fv[1]; sc[4 * g + 2] = fv[2]; sc[4 * g + 3] = fv[3]; }
    __syncthreads();
    if (DIFF) {
        LAS float* ex = (LAS float*)(lds + (w & 3) * STG_BYTES);
        if (m) {
#pragma unroll
            for (int dh = 0; dh < NDH; ++dh)
#pragma unroll
                for (int r = 0; r < 16; ++r) ex[(dh * 16 + r) * 64 + lane] = o[dh][r] * sc[r];
        }
        __syncthreads();
        if (!m) {
#pragma unroll
            for (int dh = 0; dh < NDH; ++dh)
#pragma unroll
                for (int r = 0; r < 16; ++r) o[dh][r] = o[dh][r] * sc[r] - ex[(dh * 16 + r) * 64 + lane];
            asm volatile("s_waitcnt lgkmcnt(0)" ::: "memory");
#pragma unroll
            for (int dh = 0; dh < NDH; ++dh)
#pragma unroll
                for (int r = 0; r < 16; ++r) ex[crow(r, hi) * 132 + dh * 32 + r32] = o[dh][r];
            asm volatile("s_waitcnt lgkmcnt(0)" ::: "memory");
            const int row = lane >> 1, half = lane & 1;
            f32x4 v[16]; float ss = 0.f;
#pragma unroll
            for (int j = 0; j < 16; ++j) { v[j] = *(const LAS f32x4*)(ex + row * 132 + half * 64 + 4 * j); ss += (v[j][0] * v[j][0] + v[j][1] * v[j][1]) + (v[j][2] * v[j][2] + v[j][3] * v[j][3]); }
            ss += __shfl_xor(ss, 1);
            const float rstd = 0.8f / sqrtf(ss * (1.f / 128.f) + EPS);
            bf16* op = mix + ((size_t)b * SEQ + r0 + row) * D + hh * 128 + half * 64;
#pragma unroll
            for (int j = 0; j < 16; j += 2) { const f32x4 g0 = *(const f32x4*)(p.subg + half * 64 + 4 * j), g1 = *(const f32x4*)(p.subg + half * 64 + 4 * j + 4);
                *(u32x4*)(op + 4 * j) = (u32x4){cvtpk(v[j][0] * rstd * g0[0], v[j][1] * rstd * g0[1]), cvtpk(v[j][2] * rstd * g0[2], v[j][3] * rstd * g0[3]), cvtpk(v[j + 1][0] * rstd * g1[0], v[j + 1][1] * rstd * g1[1]), cvtpk(v[j + 1][2] * rstd * g1[2], v[j + 1][3] * rstd * g1[3])}; }
        }
    } else {
        LAS float* ex = (LAS float*)(lds + w * 8704);
#pragma unroll
        for (int dh = 0; dh < NDH; ++dh)
#pragma unroll
            for (int r = 0; r < 16; ++r) ex[crow(r, hi) * 68 + dh * 32 + r32] = o[dh][r] * sc[r];
        asm volatile("s_waitcnt lgkmcnt(0)" ::: "memory");
        const int row = lane >> 1, half = lane & 1;
        bf16* op = mix + ((size_t)b * SEQ + r0 + row) * D + 512 + hq * 64 + half * 32;
#pragma unroll
        for (int j = 0; j < 8; j += 2) { const f32x4 a = *(const LAS f32x4*)(ex + row * 68 + half * 32 + 4 * j), c = *(const LAS f32x4*)(ex + row * 68 + half * 32 + 4 * j + 4);
            *(u32x4*)(op + 4 * j) = (u32x4){cvtpk(a[0], a[1]), cvtpk(a[2], a[3]), cvtpk(c[0], c[1]), cvtpk(c[2], c[3])}; }
    }
    __syncthreads();
}

__device__ __forceinline__ void attn_phase(Frame& F, const Ptrs& p) {
    { const float* sm = (const float*)(p.ws + WS_SM); LAS float* bt = (LAS float*)(F.lds + BT_OFF);
      for (int i = F.tid; i < 12 * 128; i += NWAVES * 64) bt[i] = sm[i] - sm[(i & ~127) + 127];
      if (F.tid < 8) bt[12 * 128 + F.tid] = p.sinks[F.tid] * LOG2E - sm[(4 + F.tid) * 128 + 127];
      if (F.tid == 8) bt[12 * 128 + 8] = sm[SM_LAM]; }
    __syncthreads();
#ifndef PROBE_ATT
#define PROBE_ATT 0
#endif
    for (int prep_ = 0; prep_ < ((PROBE_ATT == 1) ? 2 : 1); ++prep_)
    for (int v = F.vcu; v < 256; v += F.G) { const int bh = v >> 4, s = v & 15;
        attn_unit<true>(F, p, bh >> 2, bh & 3, 128 * (31 - s)); attn_unit<true>(F, p, bh >> 2, bh & 3, 128 * s); }
    for (int prep_ = 0; prep_ < ((PROBE_ATT == 2) ? 2 : 1); ++prep_)
    for (int u = F.vcu; u < 512; u += F.G) { const int bk = u >> 6, qb = u & 63; attn_unit<false>(F, p, bk >> 1, bk & 1, 64 * qb); }
}
}

struct Args { Ptrs p; int ph_lo, ph_hi, li, pad; };
__global__ void __launch_bounds__(NWAVES * 64, 2) mk(Args args) {
    extern __shared__ __attribute__((aligned(16))) unsigned char lds[];
    Frame F;
    F.lds = (LAS unsigned char*)lds; F.MISC = (volatile LAS unsigned*)(F.lds + MISC_OFF);
    F.tid = threadIdx.x; F.lane = F.tid & 63; F.wave = __builtin_amdgcn_readfirstlane(F.tid >> 6);
    F.G = gridDim.x; { const int bx = blockIdx.x; F.vcu = (F.G % 8 == 0) ? (bx % 8) * (F.G / 8) + bx / 8 : bx; }
    const Ptrs& p = args.p;
    F.ctl = (unsigned*)(p.ws + WS_CTL);
    for (int u = F.tid; u < (LDS_BYTES - LDSCTL_OFF) / 4; u += NWAVES * 64) ((LAS unsigned*)(F.lds + LDSCTL_OFF))[u] = 0u;
    __syncthreads();
    XcdBarrier bar = xcd_barrier_post(F.ctl + CW_BAR + args.li * XCD_BAR_WORDS, F.MISC + 8);
    const int lo = args.ph_lo, hi = args.ph_hi;
#define IN(k) (lo <= (k) && (k) < hi)
#define SEAM(k) do { if (IN(k) && IN((k) + 1)) xcd_barrier(bar); } while (0)

    if (IN(0)) { p0_prologue(F, p); SEAM(0); }
    if (IN(1)) {
        pg8::Gemm g{(const bf16*)(p.ws + WS_R2), (const bf16*)(p.ws + WS_WIN), MROWS, DIN, D}; pg8::StaticOrder S; S.init(MROWS, DIN, F.G, (int)blockIdx.x);
        pg8::EpiProj E{(bf16*)(p.ws + WS_R1), p.dqg, p.dkg, p.sqg, p.skg};
        pg8::gemm_phase<pg8::EpiProj, pg8::StaticOrder, true, true>(F.lds, g, S, E);
        { constexpr int NU = (MROWS / 256) * (DIN / 256); const int nheavy = NU % F.G, nlight = F.G - nheavy;
          if (nheavy == 0) convert_experts(F, p, (int)blockIdx.x, F.G); else if ((int)blockIdx.x >= nheavy) convert_experts(F, p, (int)blockIdx.x - nheavy, nlight); }
        SEAM(1);
    }
    if (IN(2)) { att::attn_phase(F, p); SEAM(2); }
    if (IN(3)) {
        pg8::Gemm g{(const bf16*)(p.ws + WS_R2), (const bf16*)(p.ws + WS_WOUT), NTOK, D, D}; pg8::StaticOrder S; S.init(NTOK, D, F.G, (int)blockIdx.x);
        pg8::EpiOut E{p.x, p.out};
        pg8::gemm_phase<pg8::EpiOut, pg8::StaticOrder, true, true>(F.lds, g, S, E);
        SEAM(3);
    }
    if (IN(4)) { p4_router(F, p); if (IN(6)) xcd_barrier(bar); }
    if (IN(6)) {
        moe_tables(F);
        const int ntile = *(const LAS int*)(F.lds + PS_OFF + 32 * 4);
        pg8::Gemm g{(const bf16*)(p.ws + WS_R1), (const bf16*)(p.ws + WS_WGU), ntile * 256, 1024, D};
        pg8::MoeOrder S; S.so.init(ntile * 256, 1024, F.G, (int)blockIdx.x); S.tile_e = (const LAS int*)(F.lds + TILEE_OFF); S.ps = (const LAS int*)(F.lds + PS_OFF);
        S.ltok = (const unsigned*)(p.ws + WS_LIST); S.cnt = F.ctl + CW_CNT;
        pg8::EpiGU E{(bf16*)(p.ws + WS_R2)};
        pg8::gemm_phase<pg8::EpiGU, pg8::MoeOrder, true, true, true>(F.lds, g, S, E);
        SEAM(6);
    }
    if (IN(7)) {
        moe_tables(F);
        const int ntile = *(const LAS int*)(F.lds + PS_OFF + 32 * 4);
        pg8::Gemm g{(const bf16*)(p.ws + WS_R2), (const bf16*)(p.ws + WS_WD), ntile * 256, 1024, DEXP};
        pg8::MoeOrder S; S.so.init(ntile * 256, 1024, F.G, (int)blockIdx.x); S.tile_e = (const LAS int*)(F.lds + TILEE_OFF); S.ps = (const LAS int*)(F.lds + PS_OFF);
        S.ltok = (const unsigned*)(p.ws + WS_LIST); S.cnt = F.ctl + CW_CNT;
        pg8::EpiDown E{(bf16*)(p.ws + WS_R1), (const float*)(p.ws + WS_LIST + (size_t)NEXP * LISTCAP * 4), (const LAS int*)(F.lds + PS_OFF)};
        pg8::gemm_phase<pg8::EpiDown, pg8::MoeOrder, true, true>(F.lds, g, S, E);
        SEAM(7);
    }
    if (IN(8)) { moe_tables(F); p8_combine(F, p); }
#undef IN
#undef SEAM
}

extern "C" void kernel_launch(void* const* d_in, const int* in_sizes, int n_in, void* d_out, int out_size, void* d_ws, size_t ws_size, hipStream_t stream) {
    static int grid = 0;
    if (grid == 0) {
        if (n_in != 24 || in_sizes[0] != NTOK * D || out_size != NTOK * D || ws_size < WS_END) { fprintf(stderr, "kernel_launch: unexpected shapes (n_in %d, in0 %d, out %d, ws %zu)\n", n_in, n_in > 0 ? in_sizes[0] : -1, out_size, ws_size); grid = -1; return; }
        int dev = 0, cus = 0, per_cu = 0;
        if (hipGetDevice(&dev) != hipSuccess || hipDeviceGetAttribute(&cus, hipDeviceAttributeMultiprocessorCount, dev) != hipSuccess) { grid = -1; return; }
        if (hipFuncSetAttribute((const void*)mk, hipFuncAttributeMaxDynamicSharedMemorySize, LDS_BYTES) != hipSuccess) { fprintf(stderr, "kernel_launch: hipFuncSetAttribute failed\n"); grid = -1; return; }
        if (hipOccupancyMaxActiveBlocksPerMultiprocessor(&per_cu, (const void*)mk, NWAVES * 64, LDS_BYTES) != hipSuccess || per_cu < 1) fprintf(stderr, "kernel_launch: occupancy query reports %d\n", per_cu);
        (void)hipGetLastError();
        grid = cus;
    }
    if (grid < 0) return;
    Args a{};
    const float** f = (const float**)&a.p;
    for (int i = 0; i < 24; ++i) f[i] = (const float*)d_in[i];
    a.p.out = (float*)d_out; a.p.ws = (unsigned char*)d_ws;
    (void)hipMemsetAsync((char*)d_ws + WS_CTL, 0, CTL_ZERO_BYTES, stream);
    a.ph_lo = 0; a.ph_hi = NPHASE; a.li = 0;
    hipLaunchKernelGGL(mk, dim3(grid), dim3(NWAVES * 64), LDS_BYTES, stream, a);
}
```
